# Optimizing an MI355X kernel written in HIP

```python
import math
import jax, jax.numpy as jnp
from jax import lax
import numpy as np

D_MODEL = 2048
BATCH = 4
SEQ = 4096
DEPTH = 1

CHUNK = 64
N_META = 16
D_MIX = D_MODEL
FOX_HEADS = 8
FOX_HEAD_DIM = 128
D_FOX = FOX_HEADS * FOX_HEAD_DIM
POOL_WINDOWS = (2, 4, 8, 16)
N_POOL_GROUPS = len(POOL_WINDOWS)
D_POOL = D_MIX - D_FOX
POOL_GROUP_DIM = D_POOL // N_POOL_GROUPS
D_IN_PROJ = 3 * D_FOX + FOX_HEADS + D_POOL
Q_BLOCK = 128
N_GROUPS = 4
EXPERTS_PER_GROUP = 8
N_EXPERTS = N_GROUPS * EXPERTS_PER_GROUP
TOP_K = 2
D_EXPERT = 1024
ROW_BLOCK = 128
LN_EPS = 1e-5
DEEPNORM_ALPHA = (2.0 * DEPTH) ** 0.25
DEEPNORM_BETA = (8.0 * DEPTH) ** -0.25

kernel_name = "fox_pool_hier_moe_deepnorm_trunk"


def layer_norm(x, g, b):
    xf = x.astype(jnp.float32)
    mu = jnp.mean(xf, axis=-1, keepdims=True)
    var = jnp.mean(jnp.square(xf - mu), axis=-1, keepdims=True)
    return ((xf - mu) * lax.rsqrt(var + LN_EPS) * g + b).astype(x.dtype)


def forgetting_attention(q, k, v, log_f):
    B_, H, L, hd = q.shape
    Lp = ((L + Q_BLOCK - 1) // Q_BLOCK) * Q_BLOCK
    pad = Lp - L
    q = jnp.pad(q, ((0, 0), (0, 0), (0, pad), (0, 0)))
    k = jnp.pad(k, ((0, 0), (0, 0), (0, pad), (0, 0)))
    v = jnp.pad(v, ((0, 0), (0, 0), (0, pad), (0, 0)))
    c = jnp.cumsum(jnp.pad(log_f, ((0, 0), (0, 0), (0, pad))), axis=-1)
    nq = Lp // Q_BLOCK
    q_blocks = q.reshape(B_, H, nq, Q_BLOCK, hd).transpose(2, 0, 1, 3, 4)
    c_blocks = c.reshape(B_, H, nq, Q_BLOCK).transpose(2, 0, 1, 3)
    starts = jnp.arange(nq, dtype=jnp.int32) * Q_BLOCK
    key_pos = jnp.arange(Lp, dtype=jnp.int32)
    scale = hd ** -0.5

    def query_block(args):
        q_i, c_i, start = args
        s = jnp.einsum('bhqd,bhkd->bhqk', q_i, k,
                       preferred_element_type=jnp.float32) * scale
        s = s + c_i[..., :, None] - c[:, :, None, :]
        causal = (start + jnp.arange(Q_BLOCK, dtype=jnp.int32))[:, None] >= key_pos[None, :]
        s = jnp.where(causal, s, -jnp.inf)
        p = jax.nn.softmax(s, axis=-1)
        return jnp.einsum('bhqk,bhkd->bhqd', p.astype(v.dtype), v)

    o = lax.map(query_block, (q_blocks, c_blocks, starts))
    o = o.transpose(1, 0, 3, 2, 4).reshape(B_, Lp, H * hd)
    return o[:, :L]


def multiscale_pool(u, pool_w, pool_scale):
    B_, L, _ = u.shape
    uf = u.astype(jnp.float32).reshape(B_, L, N_POOL_GROUPS, POOL_GROUP_DIM)
    cs = jnp.cumsum(uf, axis=1)
    t = jnp.arange(L)
    outs = []
    for g, w in enumerate(POOL_WINDOWS):
        cs_g = cs[:, :, g]
        prev = jnp.pad(cs_g, ((0, 0), (w, 0), (0, 0)))[:, :L]
        count = jnp.minimum(t + 1, w).astype(jnp.float32)[None, :, None]
        outs.append((cs_g - prev) / count - uf[:, :, g])
    pooled = jnp.stack(outs, axis=2).astype(u.dtype)
    mixed = jnp.einsum('blgc,gcd->blgd', pooled, pool_w)
    return mixed.reshape(B_, L, D_POOL) * pool_scale


def hybrid_mixer(h, w_in, b_f, pool_w, pool_scale, w_out):
    B_, L, _ = h.shape
    proj = h @ w_in
    q, k, v, f_logit, u = jnp.split(
        proj, [D_FOX, 2 * D_FOX, 3 * D_FOX, 3 * D_FOX + FOX_HEADS], axis=-1)

    def to_heads(t):
        return t.reshape(B_, L, FOX_HEADS, FOX_HEAD_DIM).transpose(0, 2, 1, 3)

    log_f = jax.nn.log_sigmoid((f_logit + b_f).astype(jnp.float32)).transpose(0, 2, 1)
    o_fox = forgetting_attention(to_heads(q), to_heads(k), to_heads(v), log_f)
    o_pool = multiscale_pool(u, pool_w, pool_scale)
    return jnp.concatenate([o_fox.astype(h.dtype), o_pool], axis=-1) @ w_out


def hierarchical_moe(h, w_rg, b_rg, w_re, b_re, w13, w2):
    B_, L, D = h.shape
    T = B_ * L
    xt = h.reshape(T, D)
    logits_g = (xt @ w_rg).astype(jnp.float32) + b_rg
    g_idx = jnp.argmax(logits_g, axis=-1)
    p_g = jnp.take_along_axis(jax.nn.softmax(logits_g, axis=-1), g_idx[:, None], axis=1)[:, 0]
    logits_e = ((xt @ w_re).astype(jnp.float32) + b_re).reshape(T, N_GROUPS, EXPERTS_PER_GROUP)
    le = jnp.take_along_axis(logits_e, g_idx[:, None, None], axis=1)[:, 0]
    top_v, top_i = lax.top_k(le, TOP_K)
    gates = (jax.nn.softmax(top_v, axis=-1) * p_g[:, None]).astype(xt.dtype)
    expert = (g_idx[:, None] * EXPERTS_PER_GROUP + top_i).astype(jnp.int32)

    A = T * TOP_K
    flat_e = expert.reshape(A)
    order = jnp.argsort(flat_e)
    e_sorted = flat_e[order]
    tok_sorted = (order // TOP_K).astype(jnp.int32)
    counts = jnp.bincount(flat_e, length=N_EXPERTS).astype(jnp.int32)
    start = jnp.cumsum(counts) - counts
    padded = ((counts + ROW_BLOCK - 1) // ROW_BLOCK) * ROW_BLOCK
    pend = jnp.cumsum(padded)
    pstart = pend - padded
    rank = jnp.arange(A, dtype=jnp.int32) - start[e_sorted]
    dest_sorted = pstart[e_sorted] + rank
    n_blocks = (A + N_EXPERTS * (ROW_BLOCK - 1) + ROW_BLOCK - 1) // ROW_BLOCK
    rows_tok = jnp.full((n_blocks * ROW_BLOCK,), T, jnp.int32).at[dest_sorted].set(tok_sorted)
    block_expert = jnp.minimum(
        jnp.searchsorted(pend, jnp.arange(n_blocks, dtype=jnp.int32) * ROW_BLOCK, side='right'),
        N_EXPERTS - 1).astype(jnp.int32)
    x_ext = jnp.concatenate([xt, jnp.zeros((1, D), xt.dtype)], axis=0)

    def expert_block(args):
        tok_idx, e = args
        xb = x_ext[tok_idx]
        gate, up = jnp.split(xb @ w13[e], 2, axis=-1)
        return (jax.nn.silu(gate) * up) @ w2[e]

    out = lax.map(expert_block, (rows_tok.reshape(n_blocks, ROW_BLOCK), block_expert))
    out = out.reshape(n_blocks * ROW_BLOCK, D)
    dest = jnp.zeros((A,), jnp.int32).at[order].set(dest_sorted)
    y = jnp.sum(out[dest].reshape(T, TOP_K, D) * gates[..., None], axis=1)
    return y.reshape(B_, L, D)


def setup_inputs(seed: int = 0) -> dict:
    key = jax.random.key(seed)
    ks = jax.random.split(key, 20)
    f32 = jnp.float32
    nrm = lambda k, s: jax.random.normal(k, s, f32)
    d = D_MODEL
    x = nrm(ks[0], (BATCH, SEQ, d))
    meta = nrm(ks[1], (N_META, d))
    ln_in_g = 1.0 + 0.02 * nrm(ks[2], (d,))
    ln_in_b = 0.02 * nrm(ks[3], (d,))
    w_in = nrm(ks[4], (DEPTH, d, D_IN_PROJ)) * d ** -0.5
    b_f = jnp.linspace(1.0, 6.0, FOX_HEADS, dtype=f32)[None, :] + 0.1 * nrm(ks[5], (DEPTH, FOX_HEADS))
    pool_w = nrm(ks[6], (DEPTH, N_POOL_GROUPS, POOL_GROUP_DIM, POOL_GROUP_DIM)) * POOL_GROUP_DIM ** -0.5
    pool_scale = 1.0 + 0.02 * nrm(ks[7], (DEPTH, D_POOL))
    w_out = nrm(ks[8], (DEPTH, D_MIX, d)) * (D_MIX ** -0.5 * DEEPNORM_BETA)
    ln_mix_g = 1.0 + 0.02 * nrm(ks[9], (DEPTH, d))
    ln_mix_b = 0.02 * nrm(ks[10], (DEPTH, d))
    w_router_g = nrm(ks[11], (DEPTH, d, N_GROUPS)) * d ** -0.5
    b_router_g = 0.01 * nrm(ks[12], (DEPTH, N_GROUPS))
    w_router_e = nrm(ks[13], (DEPTH, d, N_EXPERTS)) * d ** -0.5
    b_router_e = 0.01 * nrm(ks[14], (DEPTH, N_EXPERTS))
    w13 = nrm(ks[15], (DEPTH, N_EXPERTS, d, 2 * D_EXPERT)) * d ** -0.5
    w2 = nrm(ks[16], (DEPTH, N_EXPERTS, D_EXPERT, d)) * (D_EXPERT ** -0.5 * DEEPNORM_BETA)
    ln_ffn_g = 1.0 + 0.02 * nrm(ks[17], (DEPTH, d))
    ln_ffn_b = 0.02 * nrm(ks[18], (DEPTH, d))
    return {"x": x, "meta": meta, "ln_in_g": ln_in_g, "ln_in_b": ln_in_b,
            "w_in": w_in, "b_f": b_f, "pool_w": pool_w, "pool_scale": pool_scale,
            "w_out": w_out, "ln_mix_g": ln_mix_g, "ln_mix_b": ln_mix_b,
            "w_router_g": w_router_g, "b_router_g": b_router_g,
            "w_router_e": w_router_e, "b_router_e": b_router_e,
            "w13": w13, "w2": w2, "ln_ffn_g": ln_ffn_g, "ln_ffn_b": ln_ffn_b}


def reference(x, meta, ln_in_g, ln_in_b, w_in, b_f, pool_w, pool_scale, w_out,
              ln_mix_g, ln_mix_b, w_router_g, b_router_g, w_router_e, b_router_e,
              w13, w2, ln_ffn_g, ln_ffn_b):
    B_ = x.shape[0]
    meta_b = jnp.broadcast_to(meta[None].astype(x.dtype), (B_, N_META, D_MODEL))
    h = jnp.concatenate([meta_b, x], axis=1)
    h = layer_norm(h, ln_in_g, ln_in_b)
    for l in range(DEPTH):
        mix = hybrid_mixer(h, w_in[l], b_f[l], pool_w[l], pool_scale[l], w_out[l])
        h = layer_norm(DEEPNORM_ALPHA * h + mix, ln_mix_g[l], ln_mix_b[l])
        ffn = hierarchical_moe(h, w_router_g[l], b_router_g[l], w_router_e[l], b_router_e[l],
                               w13[l], w2[l])
        h = layer_norm(DEEPNORM_ALPHA * h + ffn, ln_ffn_g[l], ln_ffn_b[l])
    return h[:, N_META:]
```

```cpp
#include <hip/hip_runtime.h>
#include <cstdio>
#include <cstdint>

#ifndef PHMASK
#define PHMASK 0xFFFFFF
#endif
#define PH(k) (((PHMASK) >> (k)) & 1)
#ifndef STAGE
#define STAGE 9
#endif

#define LAS __attribute__((address_space(3)))
#define GAS __attribute__((address_space(1)))
typedef unsigned short bf16_t;
typedef short bf16x8 __attribute__((ext_vector_type(8)));
typedef short s16x4 __attribute__((ext_vector_type(4)));
typedef float f32x4 __attribute__((ext_vector_type(4)));
typedef float f32x2 __attribute__((ext_vector_type(2)));
typedef float f32x16 __attribute__((ext_vector_type(16)));
typedef unsigned u32x4 __attribute__((ext_vector_type(4)));
typedef unsigned u32x2 __attribute__((ext_vector_type(2)));
typedef GAS unsigned gu32;

constexpr int DM = 2048, NB = 4, SEQ = 4096, NMETA = 16, LPOS = SEQ + NMETA, TR = NB * SEQ;
constexpr int NH = 8, HD = 128, DFOX = 1024, DPOOL = 1024, NIN = 4104, NINB = 4096;
constexpr int NE = 32, EPG = 8, NGRP = 4, DE = 1024;
constexpr int KROWS = NB * LPOS + 64;
constexpr int CPOS = 4160;
constexpr int PRMAX = 41216;
constexpr float LN_EPS = 1e-5f;
constexpr float ALPHA = 1.189207115002721f;
constexpr float LOG2E = 1.4426950408889634f;
constexpr float QSCALE = 0.08838834764831845f * LOG2E;
constexpr int NWAVES = 8;

constexpr size_t MiB = 1u << 20;
constexpr size_t WS_CTL = 0, CTL_ZERO_BYTES = 1 * MiB;
constexpr size_t WS_WIN = 1 * MiB;
constexpr size_t WS_WOUT = WS_WIN + 16 * MiB;
constexpr size_t WS_WPOOL = WS_WOUT + 8 * MiB;
constexpr size_t WS_WR = WS_WPOOL + 1 * MiB;
constexpr size_t WS_W13 = WS_WR + 1 * MiB;
constexpr size_t WS_W2 = WS_W13 + 256 * MiB;
constexpr size_t WS_H0 = WS_W2 + 128 * MiB;
constexpr size_t WS_ST0 = WS_H0 + 64 * MiB;
constexpr size_t WS_LF = WS_ST0 + 1 * MiB;
constexpr size_t WS_SLAB = WS_LF + 1 * MiB;
constexpr size_t WS_Q = WS_SLAB + 3 * MiB;
constexpr size_t WS_K = WS_Q + 32 * MiB;
constexpr size_t WS_V = WS_K + 33 * MiB;
constexpr size_t WS_U = WS_V + 33 * MiB;
constexpr size_t WS_POOLED = WS_U + 33 * MiB;
constexpr size_t WS_CAT = WS_POOLED + 32 * MiB;
constexpr size_t WS_R = WS_CAT + 64 * MiB;
constexpr size_t WS_H1B = WS_R + 128 * MiB;
constexpr size_t WS_TOK = WS_H1B + 64 * MiB;
constexpr size_t WS_GATE = WS_TOK + 2 * MiB;
constexpr size_t WS_TINFO = WS_GATE + 2 * MiB;
constexpr size_t WS_HID = WS_TINFO + 1 * MiB;
constexpr size_t WS_EO = WS_HID + 81 * MiB;
constexpr size_t WS_END = WS_EO + 161 * MiB;
static_assert((size_t)KROWS * 1024 * 2 <= 33 * MiB && (size_t)PRMAX * 1024 * 2 <= 81 * MiB && (size_t)PRMAX * 2048 * 2 <= 161 * MiB, "ws map");
constexpr int CW_TMO = 0, CW_BAR = 4096, CW_CNT = 8192;

constexpr int RING_BYTES = 131072;
constexpr int LDSCTL_OFF = 161792;
constexpr int LDS_BYTES = 163840;
constexpr int LC_BAR = 0;
constexpr int LC_TST = 16;
constexpr int LC_CNT = 64;
constexpr int LC_HIST = 96, LC_BASE = 128;
constexpr int LC_MST = 160;

__device__ __forceinline__ unsigned cvt_pk_bf16(float lo, float hi) { unsigned r; asm volatile("v_cvt_pk_bf16_f32 %0, %1, %2" : "=v"(r) : "v"(lo), "v"(hi)); return r; }
__device__ __forceinline__ int fresh_tid() { int t = threadIdx.x; asm volatile("" : "+v"(t)); return t; }
__device__ __forceinline__ float bf16_lo(unsigned w) { return __uint_as_float(w << 16); }
__device__ __forceinline__ float bf16_hi(unsigned w) { return __uint_as_float(w & 0xffff0000u); }
__device__ __forceinline__ float wave_sum(float v) {
#pragma unroll
    for (int o = 1; o < 64; o <<= 1) v += __shfl_xor(v, o);
    return v;
}

namespace pg8 {
constexpr int BM = 256, BK = 64, HALF = 128, HTB = HALF * BK * 2, STAGE_BYTES = 8 * HTB, NXCD = 8, WGM = 8;
__host__ __device__ __forceinline__ int lds_byte(int r, int c) { const int st = (r >> 4) * 2 + (c >> 5), rr = r & 15, cc = c & 31, ob = rr * 64 + cc * 2; return st * 1024 + (ob ^ (((ob >> 9) & 1) << 5)); }
__host__ __device__ __forceinline__ void stage_rc(int b, int& R, int& C) { const int st = b / 1024, sb = b % 1024, swz = sb ^ (((sb >> 9) & 1) << 5); R = (st >> 1) * 16 + swz / 64; C = (st & 1) * 32 + (swz % 64) / 2; }
__host__ __device__ __forceinline__ int perm32(int rho) { const int n = rho >> 4, i = rho & 15; return 8 * (i >> 2) + 4 * n + (i & 3); }

struct Unit { int pm, pn, e, lt; };
struct Gemm { const bf16_t* A; const bf16_t* Bt; int K; int lda; int nB; };

struct StaticOrder {
    static constexpr bool GATHER = false;
    int nM, nN, nwg, G, c, lda, acol;
    __device__ void init(int M, int N, int G_, int c_, int lda_, int acol_) { nM = M / BM; nN = N / BM; nwg = nM * nN; G = G_; c = c_; lda = lda_; acol = acol_; }
    __device__ bool next(int i, Unit& u) const {
        const long L = (long)i * G + c; if (L >= nwg) return false;
        int wgid = (int)L; { const int q = nwg / NXCD, r = nwg % NXCD, xcd = wgid % NXCD, off = wgid / NXCD; wgid = (xcd < r ? xcd * (q + 1) : r * (q + 1) + (xcd - r) * q) + off; }
        const int nig = WGM * nN, gid = wgid / nig, fm = gid * WGM, gsz = (nM - fm) < WGM ? (nM - fm) : WGM;
        u.pm = fm + ((wgid % nig) % gsz); u.pn = (wgid % nig) / gsz; u.e = 0; u.lt = 0; return true;
    }
    __device__ __forceinline__ unsigned a_row(const Unit& u, int r) const { return (unsigned)(u.pm * BM + r) * (unsigned)lda + (unsigned)acol; }
};
struct OneUnit {
    static constexpr bool GATHER = false;
    Unit u0; int lda, acol;
    __device__ bool next(int i, Unit& u) const { if (i) return false; u = u0; return true; }
    __device__ __forceinline__ unsigned a_row(const Unit& u, int r) const { return (unsigned)(u.pm * BM + r) * (unsigned)lda + (unsigned)acol; }
};

template <class Epi, class Sched, bool ALIGN_EPI>
__device__ __forceinline__ void gemm_phase(LAS unsigned char* lds, const Gemm g, const Sched& S, const Epi& E) {
    const int tid = fresh_tid(), wid = __builtin_amdgcn_readfirstlane(tid >> 6), lane = tid & 63, wr = wid >> 2, wc = wid & 3, fr = lane & 15, fq = lane >> 4;
    const int K = g.K, nt = K / BK;
    unsigned voffB[2];
#pragma unroll
    for (int i = 0; i < 2; ++i) { int R, C; stage_rc(tid * 16 + i * 8192, R, C); const int Rb = Epi::PERM ? ((R & ~31) + perm32(R & 31)) : R; voffB[i] = (unsigned)(Rb * K + C) * 2u; }
    const size_t kstep = (size_t)(BK * 2);
    const size_t hstep = (size_t)HALF * K * 2;
    const unsigned ldsw = (unsigned)wid * 1024u;
    const int aoff = lds_byte(wr * 64 + fr, fq * 8), boff = lds_byte(wc * 32 + fr, fq * 8);
#define PG8_SA(b, h) (((b) * 2 + (h)) * HTB)
#define PG8_SB(b, h) ((4 + (b) * 2 + (h)) * HTB)
#define PG8_STAGE(bufoff, gbase, voff) do { _Pragma("unroll") for (int _i = 0; _i < 2; ++_i) \
        __builtin_amdgcn_global_load_lds((const unsigned*)((const char*)(gbase) + (voff)[_i]), (LAS unsigned*)(lds + (bufoff) + ldsw + _i * 8192), 16, 0, 0); } while (0)
#define PG8_LDA(dst, b, h) do { _Pragma("unroll") for (int m = 0; m < 4; ++m) _Pragma("unroll") for (int k = 0; k < 2; ++k) dst[m][k] = *(const LAS bf16x8*)(lds + PG8_SA(b, h) + aoff + m * 2048 + k * 1024); } while (0)
#define PG8_LDB(dst, b, h) do { _Pragma("unroll") for (int n = 0; n < 2; ++n) _Pragma("unroll") for (int k = 0; k < 2; ++k) dst[n][k] = *(const LAS bf16x8*)(lds + PG8_SB(b, h) + boff + n * 2048 + k * 1024); } while (0)
#define PG8_MMA(ai, bj, At, Bt) do { __builtin_amdgcn_s_setprio(1); _Pragma("unroll") for (int m = 0; m < 4; ++m) _Pragma("unroll") for (int n = 0; n < 2; ++n) _Pragma("unroll") for (int k = 0; k < 2; ++k) \
        acc[ai][bj][m][n] = __builtin_amdgcn_mfma_f32_16x16x32_bf16(Bt[n][k], At[m][k], acc[ai][bj][m][n], 0, 0, 0); __builtin_amdgcn_s_setprio(0); } while (0)
#define PG8_WAIT_V(n) asm volatile("s_waitcnt vmcnt(" #n ")" ::: "memory")
#define PG8_WAIT_L(n) asm volatile("s_waitcnt lgkmcnt(" #n ")" ::: "memory")
#define PG8_BAR __builtin_amdgcn_s_barrier()
#define PG8_SCHED __builtin_amdgcn_sched_barrier(0)
#define PG8_AOFF(dst, u) do { _Pragma("unroll") for (int _i = 0; _i < 2; ++_i) { int _R, _C; stage_rc(tid * 16 + _i * 8192, _R, _C); _Pragma("unroll") for (int _h = 0; _h < 2; ++_h) dst[_h][_i] = (S.a_row(u, _h * HALF + _R) + (unsigned)_C) * 2u; } } while (0)
    Unit cur, nxt; int ui = 0;
    if (!S.next(0, cur)) return;
    f32x4 acc[2][2][4][2];
#pragma unroll
    for (int a = 0; a < 2; ++a)
#pragma unroll
        for (int b = 0; b < 2; ++b)
#pragma unroll
            for (int m = 0; m < 4; ++m)
#pragma unroll
                for (int n = 0; n < 2; ++n) acc[a][b][m][n] = (f32x4){0.f, 0.f, 0.f, 0.f};
    bf16x8 At[4][2], B0[2][2], B1[2][2];
    unsigned oC[2][2];
    PG8_AOFF(oC, cur);
    const char* aB = (const char*)g.A;
    const char* cB = (const char*)g.Bt + ((size_t)cur.e * g.nB + (size_t)cur.pn * BM) * (size_t)K * 2;
    PG8_STAGE(PG8_SB(0, 0), cB, voffB); PG8_STAGE(PG8_SB(0, 1), cB + hstep, voffB); PG8_STAGE(PG8_SA(0, 0), aB, oC[0]); PG8_STAGE(PG8_SA(0, 1), aB, oC[1]);
    if (wr == 1) PG8_BAR;
    PG8_WAIT_V(2); PG8_BAR;
    PG8_STAGE(PG8_SB(1, 0), cB + kstep, voffB); PG8_STAGE(PG8_SA(1, 0), aB + kstep, oC[0]); PG8_STAGE(PG8_SB(1, 1), cB + hstep + kstep, voffB);
    PG8_WAIT_V(6); PG8_BAR;
    for (;;) {
        const bool has_next = S.next(ui + 1, nxt);
        if (!has_next) nxt = cur;
        unsigned oN[2][2];
        if constexpr (Sched::GATHER) { PG8_AOFF(oN, nxt); }
        const char* nB = has_next ? (const char*)g.Bt + ((size_t)nxt.e * g.nB + (size_t)nxt.pn * BM) * (size_t)K * 2 : cB;
        for (int t = 0; t < nt; t += 2) {
            const bool last = (t == nt - 2);
            const char* a1 = aB + (size_t)(t + 1) * kstep;
            const char* a2 = last ? aB : aB + (size_t)(t + 2) * kstep; const char* b2 = last ? nB : cB + (size_t)(t + 2) * kstep;
            const char* a3 = a2 + kstep; const char* b3 = b2 + kstep;
            PG8_LDB(B0, 0, 0); PG8_LDB(B1, 0, 1); PG8_SCHED; PG8_LDA(At, 0, 0); PG8_STAGE(PG8_SA(1, 1), a1, oC[1]);
            if (last) {
                if constexpr (Sched::GATHER) {
#pragma unroll
                    for (int h = 0; h < 2; ++h)
#pragma unroll
                        for (int i = 0; i < 2; ++i) oC[h][i] = oN[h][i];
                } else { PG8_AOFF(oC, nxt); } }
            PG8_WAIT_V(8); PG8_WAIT_L(0); PG8_BAR; PG8_MMA(0, 0, At, B0); PG8_MMA(0, 1, At, B1); PG8_BAR; PG8_SCHED;
            PG8_LDA(At, 0, 1); PG8_STAGE(PG8_SB(0, 0), b2, voffB); PG8_STAGE(PG8_SB(0, 1), b2 + hstep, voffB); PG8_STAGE(PG8_SA(0, 0), a2, oC[0]);
            PG8_WAIT_V(8); PG8_WAIT_L(0); PG8_BAR; PG8_MMA(1, 0, At, B0); PG8_MMA(1, 1, At, B1); PG8_BAR; PG8_SCHED;
            PG8_LDB(B0, 1, 0); PG8_LDB(B1, 1, 1); PG8_SCHED; PG8_LDA(At, 1, 0); PG8_STAGE(PG8_SA(0, 1), a2, oC[1]);
            PG8_WAIT_V(8); PG8_WAIT_L(0); PG8_BAR; PG8_MMA(0, 0, At, B0); PG8_MMA(0, 1, At, B1); PG8_BAR; PG8_SCHED;
            PG8_LDA(At, 1, 1); PG8_STAGE(PG8_SB(1, 0), b3, voffB); PG8_STAGE(PG8_SB(1, 1), b3 + hstep, voffB); PG8_STAGE(PG8_SA(1, 0), a3, oC[0]);
            PG8_WAIT_V(8); PG8_WAIT_L(0); PG8_BAR; PG8_MMA(1, 0, At, B0); PG8_MMA(1, 1, At, B1); PG8_BAR; PG8_SCHED;
        }
        if constexpr (ALIGN_EPI) { if (wr == 0) PG8_BAR; }
        E(acc, cur, wr, wc, fr, fq);
        if (!has_next) break;
#pragma unroll
        for (int a = 0; a < 2; ++a)
#pragma unroll
            for (int b = 0; b < 2; ++b)
#pragma unroll
                for (int m = 0; m < 4; ++m)
#pragma unroll
                    for (int n = 0; n < 2; ++n) acc[a][b][m][n] = (f32x4){0.f, 0.f, 0.f, 0.f};
        cur = nxt; cB = nB; ++ui;
        if constexpr (ALIGN_EPI) { if (wr == 1) PG8_BAR; }
    }
    PG8_WAIT_V(0);
    if constexpr (!ALIGN_EPI) { if (wr == 0) PG8_BAR; }
    PG8_BAR;
#undef PG8_SA
#undef PG8_SB
#undef PG8_STAGE
#undef PG8_LDA
#undef PG8_LDB
#undef PG8_MMA
#undef PG8_WAIT_V
#undef PG8_WAIT_L
#undef PG8_BAR
#undef PG8_SCHED
#undef PG8_AOFF
}
}

#define XB_TMO      128
#define XB_XCNT(j)  (256  + 64 * (j))
#define XB_XSUB(j)  (1280 + 64 * (j))
#define XB_XGEN(j)  (2304 + 64 * (j))
#define XB_TOP      3328
#define XB_TOPGEN   3392
#define XCD_BAR_WORDS 3456
#define XB_SPIN_CAP (1u << 18)
__device__ __forceinline__ unsigned xb_ld(unsigned* p)              { return __hip_atomic_load(p, __ATOMIC_RELAXED, __HIP_MEMORY_SCOPE_AGENT); }
__device__ __forceinline__ unsigned xb_add(unsigned* p, unsigned v) { return __hip_atomic_fetch_add(p, v, __ATOMIC_RELAXED, __HIP_MEMORY_SCOPE_AGENT); }
__device__ __forceinline__ unsigned xb_xcc_id() { return (unsigned)__builtin_amdgcn_s_getreg((3 << 11) | 20) & 0xFu; }
#define XB_SPIN(cond, bar) do { unsigned _sp = 0; while (cond) { __builtin_amdgcn_s_sleep(1); \
    if ((++_sp & 255u) == 0u) { if (xb_ld(&(bar)[XB_TMO])) break; if (_sp > XB_SPIN_CAP) { atomicAdd(&(bar)[XB_TMO], 1u); break; } } } } while (0)
struct XcdBarrier { unsigned* bar; unsigned x; volatile LAS unsigned* st; };
__device__ __forceinline__ XcdBarrier xcd_barrier_post(unsigned* bar, volatile LAS unsigned* st) {
    XcdBarrier b; b.bar = bar; b.x = xb_xcc_id(); b.st = st;
    if (threadIdx.x == 0) (void)xb_add(&bar[XB_XCNT(b.x)], 1u);
    return b;
}
__device__ __forceinline__ void xcd_barrier_complete(unsigned* bar, unsigned x, unsigned& nloc, unsigned& nx) {
    const unsigned G = gridDim.x * gridDim.y * gridDim.z;
    unsigned sum, cnt, mine, sp = 0u;
    for (;;) {
        sum = 0u; cnt = 0u; mine = 0u;
#pragma unroll
        for (unsigned j = 0; j < 16; ++j) { const unsigned c = xb_ld(&bar[XB_XCNT(j)]); sum += c; cnt += (c > 0u) ? 1u : 0u; mine = (j == x) ? c : mine; }
        if (sum == G) break;
        __builtin_amdgcn_s_sleep(1);
        if ((++sp & 255u) == 0u) { if (xb_ld(&bar[XB_TMO])) break; if (sp > XB_SPIN_CAP) { atomicAdd(&bar[XB_TMO], 1u); break; } }
    }
    nloc = mine > 0u ? mine : 1u; nx = cnt > 0u ? cnt : 1u;
}
__device__ __forceinline__ void xcd_barrier(const XcdBarrier& b) {
    asm volatile("s_waitcnt vmcnt(0)" ::: "memory");
    __syncthreads();
    if (threadIdx.x == 0) {
        unsigned* bar = b.bar;
        __builtin_amdgcn_s_waitcnt(0);
        unsigned nloc = b.st[0], nx = b.st[1];
        if (nloc == 0u) { xcd_barrier_complete(bar, b.x, nloc, nx); b.st[0] = nloc; b.st[1] = nx; }
        const unsigned old = xb_add(&bar[XB_XSUB(b.x)], 1u);
        const unsigned gen = old / nloc;
        if (old + 1u == (gen + 1u) * nloc) {
            __builtin_amdgcn_fence(__ATOMIC_RELEASE, "agent");
            asm volatile("s_waitcnt vmcnt(0)" ::: "memory");
            const unsigned og = xb_add(&bar[XB_TOP], 1u);
            const unsigned tg = og / nx;
            if (og + 1u == (tg + 1u) * nx) xb_add(&bar[XB_TOPGEN], 1u);
            else XB_SPIN(xb_ld(&bar[XB_TOPGEN]) == tg, bar);
            __builtin_amdgcn_fence(__ATOMIC_ACQUIRE, "agent");
            xb_add(&bar[XB_XGEN(b.x)], 1u);
            asm volatile("s_waitcnt vmcnt(0)" ::: "memory");
        } else {
            XB_SPIN(xb_ld(&bar[XB_XGEN(b.x)]) == gen, bar);
            __builtin_amdgcn_fence(__ATOMIC_ACQUIRE, "agent");
            asm volatile("s_waitcnt vmcnt(0)" ::: "memory");
        }
    }
    __syncthreads();
}

namespace fox {
constexpr int D = 128, NW = 8, QBLK = 32, KVBLK = 64, QB = NW * QBLK;
constexpr int SHM_V = KVBLK * D * 2, SHM_K = KVBLK * D * 2;
constexpr int LDS_WS = 2 * SHM_V + 2 * SHM_K;
constexpr int LDS_C = LDS_WS + NW * 64 * 4;
constexpr int LDS_SC = LDS_C + CPOS * 4;
constexpr int LDS_END = LDS_SC + 64;
constexpr int KP = 1024, OP = 2048;
constexpr float THRL = 8.f * LOG2E;
#define KSWZ(row, colB) ((row) * 256 + ((colB) ^ (((row) & 7) << 4)))
#define SBAR() __builtin_amdgcn_sched_barrier(0)
__device__ __forceinline__ int v_st(int k, int c) { const int kk = (k & ~0xC) | ((k & 4) << 1) | ((k & 8) >> 1); return ((kk >> 3) * 4 + (c >> 5)) * 512 + ((kk & 7) * 32 + (c & 31)) * 2; }
__device__ __forceinline__ int v_rd_base(int lane) { return ((lane & 3) << 3) | (((lane >> 2) & 3) << 6) | (((lane >> 4) & 1) << 5) | (((lane >> 5) & 1) << 8); }
constexpr int v_rd_off(int d0, int ks, int half) { return d0 * 512 + ks * 4096 + half * 2048; }
__device__ __forceinline__ int crow(int r, int hi) { return (r & 3) + 8 * (r >> 2) + 4 * hi; }
__device__ __forceinline__ unsigned cvtpk(float lo, float hi) { unsigned r; asm volatile("v_cvt_pk_bf16_f32 %0, %1, %2" : "=v"(r) : "v"(lo), "v"(hi)); return r; }
__device__ __forceinline__ bf16x8 load8(const bf16_t* p) { return *reinterpret_cast<const bf16x8*>(p); }
__device__ __forceinline__ void mask_tile(f32x16& p0, f32x16& p1, int dq) {
    const float NEG = -__builtin_inff();
#pragma unroll
    for (int r = 0; r < 16; ++r) {
        const int c = (r & 3) + 8 * (r >> 2);
        if (dq - c < 0) p0[r] = NEG;
        if (dq - c - 32 < 0) p1[r] = NEG;
    }
}
__device__ __forceinline__ void partialSM(f32x16& p0, f32x16& p1, float& m_reg, float& mn, float& alpha) {
    float pmax = p0[0]; for (int r = 1; r < 16; ++r) pmax = fmaxf(pmax, p0[r]); for (int r = 0; r < 16; ++r) pmax = fmaxf(pmax, p1[r]);
    { auto rr = __builtin_amdgcn_permlane32_swap(__float_as_uint(pmax), __float_as_uint(pmax), false, false);
      pmax = fmaxf(__uint_as_float(rr[0]), __uint_as_float(rr[1])); }
    if (__builtin_expect(__all((pmax - m_reg) <= THRL), 1)) { mn = m_reg; alpha = 1.f; }
    else { mn = fmaxf(m_reg, pmax); alpha = __builtin_amdgcn_exp2f(m_reg - mn); m_reg = mn; }
    for (int r = 0; r < 16; ++r) p0[r] = p0[r] - mn; for (int r = 0; r < 16; ++r) p1[r] = p1[r] - mn;
    for (int r = 0; r < 16; ++r) p0[r] = __builtin_amdgcn_exp2f(p0[r]);
}
__device__ __forceinline__ void finishSM(f32x16& p0, f32x16& p1, float alpha, float& l_reg, bf16x8& pa0, bf16x8& pa1, bf16x8& pa2, bf16x8& pa3) {
    for (int r = 0; r < 16; ++r) p1[r] = __builtin_amdgcn_exp2f(p1[r]);
    float ps = 0; for (int r = 0; r < 16; ++r) ps += p0[r]; for (int r = 0; r < 16; ++r) ps += p1[r];
    { auto rr = __builtin_amdgcn_permlane32_swap(__float_as_uint(ps), __float_as_uint(ps), false, false);
      ps = __uint_as_float(rr[0]) + __uint_as_float(rr[1]); }
    l_reg = l_reg * alpha + ps;
#define PK4(P, B_, OUT) do { unsigned a0 = cvtpk(P[B_+0], P[B_+1]), a1 = cvtpk(P[B_+2], P[B_+3]);                          \
        unsigned b0 = cvtpk(P[B_+4], P[B_+5]), b1 = cvtpk(P[B_+6], P[B_+7]);                                             \
        auto r0 = __builtin_amdgcn_permlane32_swap(a0, b0, false, false); auto r1 = __builtin_amdgcn_permlane32_swap(a1, b1, false, false); \
        u32x4 w = {r0[0], r1[0], r0[1], r1[1]}; OUT = *reinterpret_cast<bf16x8*>(&w); } while (0)
    PK4(p0, 0, pa0); PK4(p0, 8, pa1); PK4(p1, 0, pa2); PK4(p1, 8, pa3);
#undef PK4
}
template <int KB>
__device__ __forceinline__ void qkt(f32x16& p0, f32x16& p1, const char* K_lds, int r32, int hi, const bf16x8* qr, const f32x4* cp) {
    { const f32x4 a0 = cp[0], a1 = cp[2], a2 = cp[4], a3 = cp[6], b0 = cp[8], b1 = cp[10], b2 = cp[12], b3 = cp[14];
      p0 = (f32x16){a0[0], a0[1], a0[2], a0[3], a1[0], a1[1], a1[2], a1[3], a2[0], a2[1], a2[2], a2[3], a3[0], a3[1], a3[2], a3[3]};
      p1 = (f32x16){b0[0], b0[1], b0[2], b0[3], b1[0], b1[1], b1[2], b1[3], b2[0], b2[1], b2[2], b2[3], b3[0], b3[1], b3[2], b3[3]}; }
    const char* kb[4];
#pragma unroll
    for (int dd = 0; dd < 4; ++dd) kb[dd] = K_lds + KB * SHM_K + KSWZ(r32, (dd * 16 + hi * 8) * 2);
#pragma unroll
    for (int d0 = 0; d0 < 8; ++d0) { const char* a = kb[d0 & 3] + (d0 >> 2) * 128;
        bf16x8 b0 = *reinterpret_cast<const bf16x8*>(a);
        bf16x8 b1 = *reinterpret_cast<const bf16x8*>(a + 32 * 256);
        p0 = __builtin_amdgcn_mfma_f32_32x32x16_bf16(b0, qr[d0], p0, 0, 0, 0);
        p1 = __builtin_amdgcn_mfma_f32_32x32x16_bf16(b1, qr[d0], p1, 0, 0, 0); }
}
template <int VB>
__device__ __forceinline__ void pv_tile(f32x16* o, int vb0, bf16x8 pa0, bf16x8 pa1, bf16x8 pa2, bf16x8 pa3) {
#define TRRD(dst, off) asm volatile("ds_read_b64_tr_b16 %0, %1 offset:%2" : "=&v"(dst) : "v"(vb0), "i"(off) : "memory")
#define PV_D0(d0) do { s16x4 l0, l1, l2, l3, h0, h1, h2, h3; constexpr int b_ = VB * SHM_V + v_rd_off(d0, 0, 0); \
        TRRD(l0, b_); TRRD(h0, b_ + 2048); TRRD(l1, b_ + 4096); TRRD(h1, b_ + 6144); TRRD(l2, b_ + 8192); TRRD(h2, b_ + 10240); TRRD(l3, b_ + 12288); TRRD(h3, b_ + 14336); \
        asm volatile("s_waitcnt lgkmcnt(0)" ::: "memory"); SBAR();   \
        o[d0] = __builtin_amdgcn_mfma_f32_32x32x16_bf16(pa0, (bf16x8){l0[0], l0[1], l0[2], l0[3], h0[0], h0[1], h0[2], h0[3]}, o[d0], 0, 0, 0);   \
        o[d0] = __builtin_amdgcn_mfma_f32_32x32x16_bf16(pa1, (bf16x8){l1[0], l1[1], l1[2], l1[3], h1[0], h1[1], h1[2], h1[3]}, o[d0], 0, 0, 0);   \
        o[d0] = __builtin_amdgcn_mfma_f32_32x32x16_bf16(pa2, (bf16x8){l2[0], l2[1], l2[2], l2[3], h2[0], h2[1], h2[2], h2[3]}, o[d0], 0, 0, 0);   \
        o[d0] = __builtin_amdgcn_mfma_f32_32x32x16_bf16(pa3, (bf16x8){l3[0], l3[1], l3[2], l3[3], h3[0], h3[1], h3[2], h3[3]}, o[d0], 0, 0, 0); } while (0)
    PV_D0(0); PV_D0(1); PV_D0(2); PV_D0(3);
#undef PV_D0
#undef TRRD
}
struct BlockRef { const bf16_t* Q; const bf16_t* K; const bf16_t* V; bf16_t* O; int P0; };
struct Seam { bf16x8 qr[8]; bf16x8 st_v0, st_v1, st_k0, st_k1; };
#define ROW(p, k0, rr) ((p) + (size_t)((k0) + (rr)) * KP + sc)
#define VMW() asm volatile("s_waitcnt vmcnt(0)" ::: "memory")
#define VMWN(n) asm volatile("s_waitcnt vmcnt(%0)" :: "i"(n) : "memory")
#define SLOAD_H(Kp, Vp, k0) do { S.st_v0 = load8(ROW(Vp, k0, sr)); S.st_v1 = load8(ROW(Vp, k0, 32 + sr));              \
                         S.st_k0 = load8(ROW(Kp, k0, sr)); S.st_k1 = load8(ROW(Kp, k0, 32 + sr)); } while (0)
#define SWRITE_HK(bf) do { *(bf16x8*)(K_lds + (bf) * SHM_K + kws) = S.st_k0; *(bf16x8*)(K_lds + (bf) * SHM_K + kws + 32 * 256) = S.st_k1; } while (0)
#define SWRITE_HV(bf) do { *(bf16x8*)(V_lds + (bf) * SHM_V + vst0) = S.st_v0; *(bf16x8*)(V_lds + (bf) * SHM_V + vst1) = S.st_v1; } while (0)
#define SWRITE_H(bf) do { SWRITE_HV(bf); SWRITE_HK(bf); } while (0)
__device__ __forceinline__ void prime(const BlockRef& cur, char* lds, Seam& S) {
    const int tid = fresh_tid(), wid = __builtin_amdgcn_readfirstlane(tid >> 6), lane = tid & 63, r32 = lane & 31, hi = lane >> 5;
    const int sr = tid >> 4, sc = (tid & 15) * 8, kws = KSWZ(sr, sc * 2); char* K_lds = lds + 2 * SHM_V;
    for (int d0 = 0; d0 < 8; ++d0) S.qr[d0] = load8(cur.Q + (size_t)(wid * QBLK + r32) * KP + d0 * 16 + hi * 8);
    SLOAD_H(cur.K, cur.V, 0); VMW(); SWRITE_HK(0);
    __syncthreads();
}
__device__ __forceinline__ void block(const BlockRef& cur, const BlockRef& nxt, char* lds, Seam& S) {
    const int tid = fresh_tid(), wid = __builtin_amdgcn_readfirstlane(tid >> 6), lane = tid & 63, r32 = lane & 31, hi = lane >> 5;
    const int NT = (cur.P0 + QB - 1) / KVBLK + 1;
    const int qlo = cur.P0 + wid * QBLK, qm = qlo + r32 - 4 * hi;
    char* V_lds = lds; char* K_lds = lds + 2 * SHM_V;
    float* ws = (float*)(lds + LDS_WS) + wid * 64; float* li_l = ws, * al_l = ws + 32;
    const f32x4* cl = (const f32x4*)(lds + LDS_C) + hi;
    float m_reg = -1e30f, l_reg = 0; f32x16 o[4] = {};
    const int sr = tid >> 4, sc = (tid & 15) * 8, vst0 = v_st(sr, sc), vst1 = v_st(32 + sr, sc), kws = KSWZ(sr, sc * 2);
    const int vb0 = (int)(uintptr_t)V_lds + v_rd_base(lane);
    const bf16_t* Kh = cur.K; const bf16_t* Vh = cur.V;
#define RESC(a) do { if (__any((a) < 1.f)) { if (hi == 0) al_l[r32] = (a); asm volatile("s_waitcnt lgkmcnt(0)" ::: "memory");              \
                     for (int d_ = 0; d_ < 4; ++d_) for (int r = 0; r < 16; ++r) o[d_][r] *= al_l[crow(r, hi)]; } } while (0)
#define KBASE(t) ((t) * KVBLK)
#define CP(t) (cl + (t) * (KVBLK / 4))
#define MASKT(P0_, P1_, t) do { const int kb_ = KBASE(t); if (kb_ + KVBLK - 1 > qlo) mask_tile(P0_, P1_, qm - kb_); } while (0)
    constexpr int NQL = 8;
#define SEAM_K0() do { VMWN(NQL); SWRITE_HK(0); SBAR(); } while (0)
    f32x16 pA0, pA1, pB0, pB1; float mnA, mnB, alA, alB; bf16x8 pa0, pa1, pa2, pa3;
    SWRITE_HV(0); SBAR();
    if (NT > 1) { SLOAD_H(Kh, Vh, KBASE(1)); }
    SBAR(); qkt<0>(pA0, pA1, K_lds, r32, hi, S.qr, CP(0));
    MASKT(pA0, pA1, 0); partialSM(pA0, pA1, m_reg, mnA, alA);
    if (NT > 1) { VMW(); SWRITE_H(1); }
    __syncthreads();
#define HALF_STEP(PX0, PX1, mnX, alX, PY0, PY1, alY, t, KB, VB, SB) do {                                                      \
        SBAR(); qkt<KB>(PX0, PX1, K_lds, r32, hi, S.qr, CP(t));                                                              \
        finishSM(PY0, PY1, alY, l_reg, pa0, pa1, pa2, pa3); SBAR();                                                           \
        if ((t) + 1 < NT) { SLOAD_H(Kh, Vh, KBASE((t) + 1)); SBAR(); }                                                        \
        pv_tile<VB>(o, vb0, pa0, pa1, pa2, pa3); MASKT(PX0, PX1, (t)); partialSM(PX0, PX1, m_reg, mnX, alX);                  \
        __syncthreads();                                                                                                      \
        if ((t) + 1 < NT) { VMW(); SWRITE_H(SB); }                                                                            \
        RESC(alX); __syncthreads(); } while (0)
    for (int t = 1; t + 1 < NT; t += 2) {
        HALF_STEP(pB0, pB1, mnB, alB, pA0, pA1, alA, t, 1, 0, 0);
        HALF_STEP(pA0, pA1, mnA, alA, pB0, pB1, alB, t + 1, 0, 1, 1);
    }
    const bool even = (NT & 1) == 0;
    if (even) { SBAR(); qkt<1>(pB0, pB1, K_lds, r32, hi, S.qr, CP(NT - 1)); SBAR(); }
    SLOAD_H(nxt.K, nxt.V, 0); SBAR();
#pragma unroll
    for (int d0 = 0; d0 < 8; ++d0) S.qr[d0] = load8(nxt.Q + (size_t)(wid * QBLK + r32) * KP + d0 * 16 + hi * 8);
    SBAR();
    finishSM(pA0, pA1, alA, l_reg, pa0, pa1, pa2, pa3); SBAR();
    pv_tile<0>(o, vb0, pa0, pa1, pa2, pa3);
    if (even) { MASKT(pB0, pB1, NT - 1); partialSM(pB0, pB1, m_reg, mnB, alB); __syncthreads(); RESC(alB);
        finishSM(pB0, pB1, alB, l_reg, pa0, pa1, pa2, pa3); SBAR(); pv_tile<1>(o, vb0, pa0, pa1, pa2, pa3); }
    SBAR(); SEAM_K0();
    if (hi == 0) li_l[r32] = l_reg; asm volatile("s_waitcnt lgkmcnt(0)" ::: "memory");
    float rli[16];
#pragma unroll
    for (int r = 0; r < 16; ++r) rli[r] = __builtin_amdgcn_rcpf(li_l[crow(r, hi)]);
    bf16_t* Ow = cur.O + (size_t)(wid * QBLK) * OP;
#pragma unroll
    for (int r = 0; r < 16; ++r) { const int orow = crow(r, hi);
#pragma unroll
        for (int d0 = 0; d0 < 4; ++d0) { const float v = o[d0][r] * rli[r];
            const float vn = __shfl_xor(v, 1);
            if ((r32 & 1) == 0) *(unsigned*)(Ow + (size_t)orow * OP + d0 * 32 + r32) = cvtpk(v, vn); } }
    __syncthreads();
#undef RESC
#undef KBASE
#undef CP
#undef MASKT
#undef SEAM_K0
#undef HALF_STEP
}
#undef ROW
#undef VMW
#undef VMWN
#undef SLOAD_H
#undef SWRITE_HK
#undef SWRITE_HV
#undef SWRITE_H
#undef KSWZ
#undef SBAR
}

struct Args {
    const float* in[19]; float* out; unsigned char* ws;
};
struct Frame {
    LAS unsigned char* lds; volatile LAS unsigned* LC; gu32* ctl; unsigned char* ws;
    int tid, lane, wave, vcu, G;
};

struct EpiIn {
            static constexpr bool PERM = true;
            bf16_t *Q, *K, *V, *U;
            __device__ __forceinline__ void operator()(const f32x4 (&acc)[2][2][4][2], const pg8::Unit& u, int wr, int wc, int fr, int fq) const {
                const int ty = u.pn >> 2, b = u.pm >> 4; const float sc = ty == 0 ? QSCALE : 1.f;
                bf16_t* base = ty == 0 ? Q : (ty == 1 ? K : (ty == 2 ? V : U));
                const int rowoff = ty == 0 ? 0 : NMETA * (b + 1);
                const int row0 = u.pm * 256 + rowoff + wr * 64 + fr, col0 = (u.pn & 3) * 256 + wc * 32 + 8 * fq;
#pragma unroll
                for (int ai = 0; ai < 2; ++ai)
#pragma unroll
                    for (int m = 0; m < 4; ++m) { bf16_t* rowp = base + (size_t)(row0 + ai * 128 + m * 16) * 1024 + col0;
#pragma unroll
                        for (int bj = 0; bj < 2; ++bj) { const f32x4 v0 = acc[ai][bj][m][0] * sc, v1 = acc[ai][bj][m][1] * sc;
                            u32x4 w; w.x = cvt_pk_bf16(v0[0], v0[1]); w.y = cvt_pk_bf16(v0[2], v0[3]); w.z = cvt_pk_bf16(v1[0], v1[1]); w.w = cvt_pk_bf16(v1[2], v1[3]);
                            *(u32x4*)(rowp + bj * 128) = w; } }
            }
        };
struct EpiPool {
                static constexpr bool PERM = true;
                bf16_t* O; const float* scale;
                __device__ __forceinline__ void operator()(const f32x4 (&acc)[2][2][4][2], const pg8::Unit& u, int wr, int wc, int fr, int fq) const {
                    const int row0 = u.pm * 256 + wr * 64 + fr, cl0 = wc * 32 + 8 * fq;
#pragma unroll
                    for (int bj = 0; bj < 2; ++bj) { const f32x4 s0 = *(const f32x4*)(scale + u.e * 256 + bj * 128 + cl0), s1 = *(const f32x4*)(scale + u.e * 256 + bj * 128 + cl0 + 4);
#pragma unroll
                        for (int ai = 0; ai < 2; ++ai)
#pragma unroll
                            for (int m = 0; m < 4; ++m) { const f32x4 v0 = acc[ai][bj][m][0] * s0, v1 = acc[ai][bj][m][1] * s1;
                                u32x4 w; w.x = cvt_pk_bf16(v0[0], v0[1]); w.y = cvt_pk_bf16(v0[2], v0[3]); w.z = cvt_pk_bf16(v1[0], v1[1]); w.w = cvt_pk_bf16(v1[2], v1[3]);
                                *(u32x4*)(O + (size_t)(row0 + ai * 128 + m * 16) * DM + DFOX + u.e * 256 + bj * 128 + cl0) = w; } }
                }
            };
struct EpiRes {
            static constexpr bool PERM = false;
            const float* x; const f32x2* st; const float* g; const float* b; float* R;
            __device__ __forceinline__ void operator()(const f32x4 (&acc)[2][2][4][2], const pg8::Unit& u, int wr, int wc, int fr, int fq) const {
                const int col0 = u.pn * 256 + wc * 32 + 4 * fq;
                f32x4 gv[2][2], bv[2][2];
#pragma unroll
                for (int bj = 0; bj < 2; ++bj)
#pragma unroll
                    for (int n = 0; n < 2; ++n) { gv[bj][n] = *(const f32x4*)(g + col0 + bj * 128 + n * 16); bv[bj][n] = *(const f32x4*)(b + col0 + bj * 128 + n * 16); }
#pragma unroll
                for (int ai = 0; ai < 2; ++ai)
#pragma unroll
                    for (int m = 0; m < 4; ++m) { const int r = u.pm * 256 + ai * 128 + wr * 64 + m * 16 + fr; const f32x2 s = st[r]; const size_t off = (size_t)r * DM + col0;
#pragma unroll
                        for (int bj = 0; bj < 2; ++bj)
#pragma unroll
                            for (int n = 0; n < 2; ++n) { const f32x4 xv = *(const f32x4*)(x + off + bj * 128 + n * 16);
                                const f32x4 h0 = (xv - s.x) * s.y * gv[bj][n] + bv[bj][n];
                                *(f32x4*)(R + off + bj * 128 + n * 16) = h0 * ALPHA + acc[ai][bj][m][n]; } }
            }
        };
template <bool GATHER_> struct MoeSched {
            static constexpr bool GATHER = GATHER_;
            volatile LAS int* TST; volatile LAS int* CNT; const int* TOK; int G, vcu, lda;
            __device__ bool next(int i, pg8::Unit& u) const {
                const int L = i * G + vcu, tile = L >> 3; if (tile >= TST[NE]) return false;
                int e = 0; while (e < NE - 1 && TST[e + 1] <= tile) ++e;
                u.pm = tile; u.pn = L & 7; u.e = e; u.lt = tile - TST[e]; return true;
            }
            __device__ __forceinline__ unsigned a_row(const pg8::Unit& u, int r) const {
                if constexpr (GATHER_) { const int pos = u.lt * 256 + r; const int tok = pos < CNT[u.e] ? TOK[(size_t)u.e * TR + pos] : 0; return (unsigned)tok * (unsigned)lda; }
                return (unsigned)(u.pm * 256 + r) * (unsigned)lda;
            }
        };
struct EpiSwi {
                static constexpr bool PERM = true;
                bf16_t* HID;
                __device__ __forceinline__ void operator()(const f32x4 (&acc)[2][2][4][2], const pg8::Unit& u, int wr, int wc, int fr, int fq) const {
                    const int row0 = u.pm * 256 + wr * 64 + fr, col0 = u.pn * 128 + wc * 32 + 8 * fq;
#pragma unroll
                    for (int ai = 0; ai < 2; ++ai)
#pragma unroll
                        for (int m = 0; m < 4; ++m) { float hv[8];
#pragma unroll
                            for (int n = 0; n < 2; ++n)
#pragma unroll
                                for (int e = 0; e < 4; ++e) { const float gt = acc[ai][0][m][n][e], up = acc[ai][1][m][n][e];
                                    hv[4 * n + e] = gt * __builtin_amdgcn_rcpf(1.f + __builtin_amdgcn_exp2f(-gt * LOG2E)) * up; }
                            u32x4 w; w.x = cvt_pk_bf16(hv[0], hv[1]); w.y = cvt_pk_bf16(hv[2], hv[3]); w.z = cvt_pk_bf16(hv[4], hv[5]); w.w = cvt_pk_bf16(hv[6], hv[7]);
                            *(u32x4*)(HID + (size_t)(row0 + ai * 128 + m * 16) * DE + col0) = w; }
                }
            };
struct EpiDown {
                static constexpr bool PERM = true;
                bf16_t* EO; const float* GATE; volatile LAS int* CNT;
                __device__ __forceinline__ void operator()(const f32x4 (&acc)[2][2][4][2], const pg8::Unit& u, int wr, int wc, int fr, int fq) const {
                    const int rl0 = wr * 64 + fr, col0 = u.pn * 256 + wc * 32 + 8 * fq, cnt = CNT[u.e];
#pragma unroll
                    for (int ai = 0; ai < 2; ++ai)
#pragma unroll
                        for (int m = 0; m < 4; ++m) { const int rl = rl0 + ai * 128 + m * 16, pos = u.lt * 256 + rl; const float gt = pos < cnt ? GATE[(size_t)u.e * TR + pos] : 0.f;
                            bf16_t* rowp = EO + (size_t)(u.pm * 256 + rl) * DM + col0;
#pragma unroll
                            for (int bj = 0; bj < 2; ++bj) { const f32x4 v0 = acc[ai][bj][m][0] * gt, v1 = acc[ai][bj][m][1] * gt;
                                u32x4 w; w.x = cvt_pk_bf16(v0[0], v0[1]); w.y = cvt_pk_bf16(v0[2], v0[3]); w.z = cvt_pk_bf16(v1[0], v1[1]); w.w = cvt_pk_bf16(v1[2], v1[3]);
                                *(u32x4*)(rowp + bj * 128) = w; } }
                }
            };

__device__ __forceinline__ void transpose_item(const float* W, int ldw, int k0, int n0s, bf16_t* WT, int ldd, int n0d, LAS float* scr, int lane) {
#pragma unroll 8
    for (int i = 0; i < 32; ++i) { const int kk = 2 * i + (lane >> 5); scr[kk * 33 + (lane & 31)] = W[(size_t)(k0 + kk) * ldw + n0s + (lane & 31)]; }
    asm volatile("s_waitcnt lgkmcnt(0)" ::: "memory");
    const int c = lane & 7;
#pragma unroll
    for (int j = 0; j < 4; ++j) { const int n = (lane >> 3) + 8 * j; const LAS float* s = scr + (8 * c) * 33 + n;
        u32x4 o; o.x = cvt_pk_bf16(s[0 * 33], s[1 * 33]); o.y = cvt_pk_bf16(s[2 * 33], s[3 * 33]); o.z = cvt_pk_bf16(s[4 * 33], s[5 * 33]); o.w = cvt_pk_bf16(s[6 * 33], s[7 * 33]);
        *(GAS u32x4*)(WT + (size_t)(n0d + n) * ldd + k0 + 8 * c) = o; }
    asm volatile("s_waitcnt lgkmcnt(0)" ::: "memory");
}
__device__ __forceinline__ void router_item(const float* W, int ncols, int col, int drow, bf16_t* WH, bf16_t* WL, int lane) {
    for (int k = lane; k < DM; k += 64) { const float w = W[(size_t)k * ncols + col]; const unsigned h = cvt_pk_bf16(w, 0.f) & 0xffffu; const float r = w - __uint_as_float(h << 16);
        WH[(size_t)drow * DM + k] = (bf16_t)h; WL[(size_t)drow * DM + k] = (bf16_t)(cvt_pk_bf16(r, 0.f) & 0xffffu); }
}

__device__ __forceinline__ float log_sigmoid_f(float z) { return fminf(z, 0.f) - log1pf(__expf(-fabsf(z))); }

extern "C" __global__ void __launch_bounds__(NWAVES * 64, 2) fox_moe_fwd(Args args) {
    extern __shared__ __attribute__((aligned(16))) unsigned char lds_raw[];
    Frame F;
    F.lds = (LAS unsigned char*)lds_raw; F.LC = (volatile LAS unsigned*)(F.lds + LDSCTL_OFF);
    F.tid = threadIdx.x; F.lane = F.tid & 63; F.wave = __builtin_amdgcn_readfirstlane(F.tid >> 6);
    F.G = gridDim.x; { const int bx = blockIdx.x; F.vcu = (F.G % 8 == 0) ? (bx % 8) * (F.G / 8) + bx / 8 : bx; }
    F.ws = args.ws; F.ctl = (gu32*)(args.ws + WS_CTL);
    const int tid = F.tid, lane = F.lane, wave = F.wave, G = F.G, vcu = F.vcu;
    for (int u = tid; u < (LDS_BYTES - LDSCTL_OFF) / 4; u += NWAVES * 64) ((LAS unsigned*)(F.lds + LDSCTL_OFF))[u] = 0u;
    __syncthreads();
    XcdBarrier bar = xcd_barrier_post((unsigned*)(F.ctl + CW_BAR), F.LC + LC_BAR);

    const float* x = args.in[0]; const float* meta = args.in[1]; const float* ln_in_g = args.in[2]; const float* ln_in_b = args.in[3];
    const float* w_in = args.in[4]; const float* b_f = args.in[5]; const float* pool_w = args.in[6]; const float* pool_scale = args.in[7];
    const float* w_out = args.in[8]; const float* ln_mix_g = args.in[9]; const float* ln_mix_b = args.in[10];
    const float* w_rg = args.in[11]; const float* b_rg = args.in[12]; const float* w_re = args.in[13]; const float* b_re = args.in[14];
    const float* w13 = args.in[15]; const float* w2 = args.in[16]; const float* ln_ffn_g = args.in[17]; const float* ln_ffn_b = args.in[18];
    float* out = args.out; unsigned char* ws = args.ws;
    bf16_t* WIN = (bf16_t*)(ws + WS_WIN); bf16_t* WOUT = (bf16_t*)(ws + WS_WOUT); bf16_t* WPOOL = (bf16_t*)(ws + WS_WPOOL);
    bf16_t* WRH = (bf16_t*)(ws + WS_WR); bf16_t* WRL = WRH + 48 * DM;
    bf16_t* W13T = (bf16_t*)(ws + WS_W13); bf16_t* W2T = (bf16_t*)(ws + WS_W2);
    bf16_t* H0 = (bf16_t*)(ws + WS_H0); f32x2* ST0 = (f32x2*)(ws + WS_ST0); float* LF = (float*)(ws + WS_LF); float* SLAB = (float*)(ws + WS_SLAB);
    bf16_t* QB_ = (bf16_t*)(ws + WS_Q); bf16_t* KB_ = (bf16_t*)(ws + WS_K); bf16_t* VB_ = (bf16_t*)(ws + WS_V); bf16_t* UB_ = (bf16_t*)(ws + WS_U);
    bf16_t* POOLED = (bf16_t*)(ws + WS_POOLED); bf16_t* CAT = (bf16_t*)(ws + WS_CAT); float* R = (float*)(ws + WS_R); bf16_t* H1B = (bf16_t*)(ws + WS_H1B);
    int* TOK = (int*)(ws + WS_TOK); float* GATE = (float*)(ws + WS_GATE); int* TINFO = (int*)(ws + WS_TINFO);
    bf16_t* HID = (bf16_t*)(ws + WS_HID); bf16_t* EO = (bf16_t*)(ws + WS_EO);
    const int gw = vcu * NWAVES + wave, NGW = G * NWAVES;

    if (PH(0)) {
        const int tid = fresh_tid(), lane = tid & 63, wave = __builtin_amdgcn_readfirstlane(tid >> 6), gw = vcu * NWAVES + wave; (void)lane; (void)gw;
        LAS float* WF = (LAS float*)(F.lds);
        LAS float* scr = (LAS float*)(F.lds + 65536 + wave * 8448);
        LAS float* MST = (LAS float*)(F.LC + LC_MST);
        for (int i = tid; i < DM * 8; i += NWAVES * 64) WF[i] = w_in[(size_t)(i >> 3) * NIN + 3 * DFOX + (i & 7)];
        for (int rr = 0; rr < 2; ++rr) { const int r = 2 * wave + rr; const f32x4* xr = (const f32x4*)(meta + (size_t)r * DM) + lane; f32x4 v[8]; float s = 0.f;
#pragma unroll
            for (int j = 0; j < 8; ++j) { v[j] = xr[64 * j]; s += (v[j].x + v[j].y) + (v[j].z + v[j].w); }
            const float mean = wave_sum(s) * (1.f / DM); float s2 = 0.f;
#pragma unroll
            for (int j = 0; j < 8; ++j) { v[j] = v[j] - mean; s2 += (v[j].x * v[j].x + v[j].y * v[j].y) + (v[j].z * v[j].z + v[j].w * v[j].w); }
            const float rstd = 1.f / sqrtf(wave_sum(s2) * (1.f / DM) + LN_EPS);
            if (lane == 0) { MST[2 * r] = mean; MST[2 * r + 1] = rstd; } }
        __syncthreads();
        if (PH(16)) for (int task = gw; task < 48 * 16; task += NGW) {
            const int cg = task % 48, kc = task / 48, k0 = kc * 128, sc = cg * 64 + lane, scol = 1024 + sc + (sc >= 2048 ? 8 : 0);
#pragma unroll
            for (int q = 0; q < 2; ++q) { const int kk = lane + 64 * q; const float gg = ln_in_g[k0 + kk], bb = ln_in_b[k0 + kk];
#pragma unroll
                for (int r = 0; r < 16; ++r) scr[kk * 16 + r] = (meta[(size_t)r * DM + k0 + kk] - MST[2 * r]) * MST[2 * r + 1] * gg + bb; }
            asm volatile("s_waitcnt lgkmcnt(0)" ::: "memory");
            float acc[16];
#pragma unroll
            for (int r = 0; r < 16; ++r) acc[r] = 0.f;
            for (int kk0 = 0; kk0 < 128; kk0 += 8) { float wv[8];
#pragma unroll
                for (int u = 0; u < 8; ++u) wv[u] = w_in[(size_t)(k0 + kk0 + u) * NIN + scol];
#pragma unroll
                for (int u = 0; u < 8; ++u) { const LAS f32x4* hp = (const LAS f32x4*)(scr + (kk0 + u) * 16); const float w = wv[u];
#pragma unroll
                    for (int q = 0; q < 4; ++q) { const f32x4 h = hp[q]; acc[4 * q] += w * h.x; acc[4 * q + 1] += w * h.y; acc[4 * q + 2] += w * h.z; acc[4 * q + 3] += w * h.w; }
                    asm volatile("" : "+v"(acc[0]), "+v"(acc[4]), "+v"(acc[8]), "+v"(acc[12]) :: "memory"); } }
#pragma unroll
            for (int r = 0; r < 16; ++r) SLAB[((size_t)kc * 16 + r) * 3072 + sc] = acc[r];
            asm volatile("s_waitcnt lgkmcnt(0)" ::: "memory");
        }
        if (PH(17)) {
        f32x4 GG[8], BB[8];
#pragma unroll
        for (int j = 0; j < 8; ++j) { GG[j] = ((const f32x4*)ln_in_g)[lane + 64 * j]; BB[j] = ((const f32x4*)ln_in_b)[lane + 64 * j]; }
        for (int m = gw; m < TR + NMETA; m += NGW) {
            const bool real = m < TR; const float* src = real ? x + (size_t)m * DM : meta + (size_t)(m - TR) * DM;
            const f32x4* xr = (const f32x4*)src + lane; f32x4 v[8]; float s = 0.f;
#pragma unroll
            for (int j = 0; j < 8; ++j) { v[j] = xr[64 * j]; s += (v[j].x + v[j].y) + (v[j].z + v[j].w); }
            const float mean = wave_sum(s) * (1.f / DM); float s2 = 0.f;
#pragma unroll
            for (int j = 0; j < 8; ++j) { v[j] = v[j] - mean; s2 += (v[j].x * v[j].x + v[j].y * v[j].y) + (v[j].z * v[j].z + v[j].w * v[j].w); }
            const float rstd = 1.f / sqrtf(wave_sum(s2) * (1.f / DM) + LN_EPS);
            float fl[8];
#pragma unroll
            for (int h = 0; h < 8; ++h) fl[h] = 0.f;
#pragma unroll
            for (int j = 0; j < 8; ++j) { v[j] = v[j] * rstd * GG[j] + BB[j];
                const LAS f32x4* wp = (const LAS f32x4*)(WF + (size_t)(4 * lane + 256 * j) * 8);
#pragma unroll
                for (int e = 0; e < 4; ++e) { const f32x4 w0 = wp[2 * e], w1 = wp[2 * e + 1]; const float hv = v[j][e];
                    fl[0] += hv * w0.x; fl[1] += hv * w0.y; fl[2] += hv * w0.z; fl[3] += hv * w0.w; fl[4] += hv * w1.x; fl[5] += hv * w1.y; fl[6] += hv * w1.z; fl[7] += hv * w1.w; }
                asm volatile("" : "+v"(fl[0]), "+v"(fl[1]), "+v"(fl[2]), "+v"(fl[3]), "+v"(fl[4]), "+v"(fl[5]), "+v"(fl[6]), "+v"(fl[7]) :: "memory"); }
            if (real) {
                GAS u32x2* o8 = (GAS u32x2*)(H0 + (size_t)m * DM) + lane;
#pragma unroll
                for (int j = 0; j < 8; ++j) { u32x2 w; w.x = cvt_pk_bf16(v[j].x, v[j].y); w.y = cvt_pk_bf16(v[j].z, v[j].w); o8[64 * j] = w; }
                if (lane == 0) ST0[m] = (f32x2){mean, rstd};
            }
#pragma unroll
            for (int h = 0; h < 8; ++h) fl[h] = wave_sum(fl[h]);
            if (lane < 8) { float z = fl[0];
#pragma unroll
                for (int h = 1; h < 8; ++h) z = (lane == h) ? fl[h] : z;
                const float lfv = -LOG2E * log_sigmoid_f(z + b_f[lane]);
                if (real) { const int b = m >> 12, pos = NMETA + (m & 4095); LF[((size_t)b * NH + lane) * CPOS + pos] = lfv; }
                else { const int pos = m - TR;
#pragma unroll
                    for (int b = 0; b < NB; ++b) LF[((size_t)b * NH + lane) * CPOS + pos] = lfv; } }
        }
        }
        for (int i = gw * 64 + lane; i < NB * NH * (CPOS - LPOS); i += NGW * 64) { const int bh = i / (CPOS - LPOS), p = LPOS + i % (CPOS - LPOS); LF[(size_t)bh * CPOS + p] = 0.f; }
        for (int i = gw * 64 + lane; i < 64 * 1024 / 8; i += NGW * 64) { const u32x4 z = {0u, 0u, 0u, 0u}; const size_t o = (size_t)NB * LPOS * 1024 + (size_t)i * 8;
            *(GAS u32x4*)(KB_ + o) = z; *(GAS u32x4*)(VB_ + o) = z; *(GAS u32x4*)(UB_ + o) = z; }
        for (int c = gw; c < 48; c += NGW) {
            if (c < 4) router_item(w_rg, NGRP, c, c, WRH, WRL, lane);
            else if (c < 36) router_item(w_re, NE, c - 4, c, WRH, WRL, lane);
            else for (int k = lane; k < DM; k += 64) { WRH[(size_t)c * DM + k] = 0; WRL[(size_t)c * DM + k] = 0; }
        }
        if (PH(18)) {
            constexpr int I_IN = (DM / 64) * (NINB / 32), I_OUT = (DM / 64) * (DM / 32), I_POOL = NGRP * (256 / 64) * (256 / 32);
            constexpr int I_13E = (DM / 64) * (2 * DE / 32), I_13 = NE * I_13E, I_2E = (DE / 64) * (DM / 32), I_2 = NE * I_2E;
            constexpr int NITEMS = I_IN + I_OUT + I_POOL + I_13 + I_2;
            for (int it = gw; it < NITEMS; it += NGW) {
                int r = it;
                if (r < I_IN) { const int nblk = NINB / 32, kb = r / nblk, nb = r % nblk, n0d = 32 * nb, n0s = n0d + (n0d >= 3 * DFOX ? 8 : 0);
                    transpose_item(w_in, NIN, 64 * kb, n0s, WIN, DM, n0d, scr, lane); continue; } r -= I_IN;
                if (r < I_OUT) { const int nblk = DM / 32, kb = r / nblk, nb = r % nblk; transpose_item(w_out, DM, 64 * kb, 32 * nb, WOUT, DM, 32 * nb, scr, lane); continue; } r -= I_OUT;
                if (r < I_POOL) { const int g = r / 32, q = r % 32, kb = q / 8, nb = q % 8; transpose_item(pool_w + (size_t)g * 65536, 256, 64 * kb, 32 * nb, WPOOL + (size_t)g * 65536, 256, 32 * nb, scr, lane); continue; } r -= I_POOL;
                if (r < I_13) { const int e = r / I_13E, q = r % I_13E, nblk = 2 * DE / 32, kb = q / nblk, nb = q % nblk, n0s = 32 * nb, j = n0s % DE, up = n0s / DE, n0d = 256 * (j / 128) + 128 * up + (j % 128);
                    transpose_item(w13 + (size_t)e * DM * 2 * DE, 2 * DE, 64 * kb, n0s, W13T + (size_t)e * 2 * DE * DM, DM, n0d, scr, lane); continue; } r -= I_13;
                { const int e = r / I_2E, q = r % I_2E, nblk = DM / 32, kb = q / nblk, nb = q % nblk;
                    transpose_item(w2 + (size_t)e * DE * DM, DM, 64 * kb, 32 * nb, W2T + (size_t)e * DM * DE, DE, 32 * nb, scr, lane); }
            }
        }
    }
    xcd_barrier(bar);

    if (PH(1)) {
        const int tid = fresh_tid(), lane = tid & 63, wave = __builtin_amdgcn_readfirstlane(tid >> 6), gw = vcu * NWAVES + wave; (void)lane; (void)gw;
        for (int o = (vcu * 512 + tid) * 4; o < 16 * 3072; o += G * 512 * 4) {
            const int r = o / 3072, sc = o % 3072; f32x4 s = {0.f, 0.f, 0.f, 0.f};
#pragma unroll
            for (int kc = 0; kc < 16; ++kc) s += *(const f32x4*)(SLAB + ((size_t)kc * 16 + r) * 3072 + sc);
            u32x2 w; w.x = cvt_pk_bf16(s.x, s.y); w.y = cvt_pk_bf16(s.z, s.w);
            bf16_t* dst = sc < 1024 ? KB_ : (sc < 2048 ? VB_ : UB_);
#pragma unroll
            for (int b = 0; b < NB; ++b) *(GAS u32x2*)(dst + ((size_t)b * LPOS + r) * 1024 + (sc & 1023)) = w;
        }

        pg8::Gemm g{H0, WIN, DM, DM, 0}; pg8::StaticOrder S; S.init(TR, NINB, G, (int)blockIdx.x, DM, 0);
        EpiIn E{QB_, KB_, VB_, UB_};
        pg8::gemm_phase<EpiIn, pg8::StaticOrder, true>(F.lds, g, S, E);
    }
    xcd_barrier(bar);

    if (PH(2) && vcu < 256) { const int item = vcu;
        const int tid = fresh_tid(), lane = tid & 63, wave = __builtin_amdgcn_readfirstlane(tid >> 6), gw = vcu * NWAVES + wave; (void)lane; (void)gw;
        const int pm = item >> 2, gq = item & 3, wnd = 2 << gq;
        if (PH(19)) {
            const int cc = tid & 31, seg = tid >> 5, m0 = pm * 256 + seg * 16, b = m0 >> 12, kr0 = m0 + NMETA * (b + 1);
            const bf16_t* up = UB_ + (size_t)kr0 * 1024 + gq * 256 + cc * 8;
            float sum[8];
#pragma unroll
            for (int e = 0; e < 8; ++e) sum[e] = 0.f;
#pragma unroll 2
            for (int i = 1; i < wnd; ++i) { const u32x4 w = *(const GAS u32x4*)(up - (size_t)i * 1024);
                sum[0] += bf16_lo(w.x); sum[1] += bf16_hi(w.x); sum[2] += bf16_lo(w.y); sum[3] += bf16_hi(w.y); sum[4] += bf16_lo(w.z); sum[5] += bf16_hi(w.z); sum[6] += bf16_lo(w.w); sum[7] += bf16_hi(w.w); }
            const float inv = 1.f / (float)wnd;
#pragma unroll 4
            for (int i = 0; i < 16; ++i) {
                const u32x4 w = *(const GAS u32x4*)(up + (size_t)i * 1024); const u32x4 z = *(const GAS u32x4*)(up + (size_t)(i - wnd + 1) * 1024);
                float cur[8] = {bf16_lo(w.x), bf16_hi(w.x), bf16_lo(w.y), bf16_hi(w.y), bf16_lo(w.z), bf16_hi(w.z), bf16_lo(w.w), bf16_hi(w.w)};
                float old[8] = {bf16_lo(z.x), bf16_hi(z.x), bf16_lo(z.y), bf16_hi(z.y), bf16_lo(z.z), bf16_hi(z.z), bf16_lo(z.w), bf16_hi(z.w)};
                float o[8];
#pragma unroll
                for (int e = 0; e < 8; ++e) { sum[e] += cur[e]; o[e] = sum[e] * inv - cur[e]; sum[e] -= old[e]; }
                u32x4 ow; ow.x = cvt_pk_bf16(o[0], o[1]); ow.y = cvt_pk_bf16(o[2], o[3]); ow.z = cvt_pk_bf16(o[4], o[5]); ow.w = cvt_pk_bf16(o[6], o[7]);
                *(GAS u32x4*)(POOLED + (size_t)(m0 + i) * 1024 + gq * 256 + cc * 8) = ow;
            }
        }
        asm volatile("s_waitcnt vmcnt(0)" ::: "memory");
        __syncthreads();
        if (PH(20)) {
            int kpool = 256; asm volatile("" : "+s"(kpool));
            pg8::Gemm g{POOLED, WPOOL, kpool, 1024, 256}; pg8::OneUnit S; S.u0 = pg8::Unit{pm, 0, gq, 0}; S.lda = 1024; S.acol = gq * 256;
            EpiPool E{CAT, pool_scale};
            pg8::gemm_phase<EpiPool, pg8::OneUnit, false>(F.lds, g, S, E);
        }
#if STAGE >= 3
        if (PH(21)) {
            const int bh = item >> 3, y = item & 7, b = bh >> 3, h = bh & 7;
            char* lds = (char*)lds_raw;
            float* cl = (float*)(lds + fox::LDS_C); float* wsum = (float*)(lds + fox::LDS_SC);
            {
                const float* lf = LF + (size_t)bh * CPOS; float v[9]; float run = 0.f;
#pragma unroll
                for (int i = 0; i < 9; ++i) { const int p = tid * 9 + i; const float t = p < CPOS ? lf[p] : 0.f; run += t; v[i] = run; }
                float inc = run;
#pragma unroll
                for (int o = 1; o < 64; o <<= 1) { const float t = __shfl_up(inc, o); if (lane >= o) inc += t; }
                if (lane == 63) wsum[wave] = inc;
                __syncthreads();
                float off = inc - run;
                for (int w = 0; w < wave; ++w) off += wsum[w];
#pragma unroll
                for (int i = 0; i < 9; ++i) { const int p = tid * 9 + i; if (p < CPOS) cl[p] = v[i] + off; }
            }
            fox::BlockRef r0, r1;
            { const int i0 = y, i1 = 15 - y;
              r0.Q = QB_ + ((size_t)b * SEQ + 256 * i0) * 1024 + h * HD; r0.K = KB_ + (size_t)b * LPOS * 1024 + h * HD; r0.V = VB_ + (size_t)b * LPOS * 1024 + h * HD;
              r0.O = CAT + ((size_t)b * SEQ + 256 * i0) * DM + h * HD; r0.P0 = NMETA + 256 * i0;
              r1 = r0; r1.Q = QB_ + ((size_t)b * SEQ + 256 * i1) * 1024 + h * HD; r1.O = CAT + ((size_t)b * SEQ + 256 * i1) * DM + h * HD; r1.P0 = NMETA + 256 * i1; }
            fox::Seam S;
            fox::prime(r0, lds, S);
            fox::block(r0, r1, lds, S);
            fox::block(r1, r1, lds, S);
        }
#else
        { const bf16_t z = 0; const int bh = item >> 3, y = item & 7, b = bh >> 3, h = bh & 7;
          for (int q = 0; q < 2; ++q) { const int i0 = q ? 15 - y : y;
            for (int i = tid; i < 256 * 16; i += 512) { const int r = i >> 4, c = (i & 15) * 8; *(GAS u32x4*)(CAT + ((size_t)b * SEQ + 256 * i0 + r) * DM + h * HD + c) = (u32x4){0u, 0u, 0u, 0u}; } } (void)z; }
#endif
        asm volatile("s_waitcnt vmcnt(0)" ::: "memory");
        __syncthreads();
    }
    xcd_barrier(bar);

    if (PH(4)) {
        const int tid = fresh_tid(), lane = tid & 63, wave = __builtin_amdgcn_readfirstlane(tid >> 6), gw = vcu * NWAVES + wave; (void)lane; (void)gw;

        pg8::Gemm g{CAT, WOUT, DM, DM, 0}; pg8::StaticOrder S; S.init(TR, DM, G, (int)blockIdx.x, DM, 0);
        EpiRes E{x, ST0, ln_in_g, ln_in_b, R};
        pg8::gemm_phase<EpiRes, pg8::StaticOrder, true>(F.lds, g, S, E);
    }
    xcd_barrier(bar);

    if (PH(5)) {
        const int tid = fresh_tid(), lane = tid & 63, wave = __builtin_amdgcn_readfirstlane(tid >> 6), gw = vcu * NWAVES + wave; (void)lane; (void)gw;
        constexpr int APITCH = 4112;
        LAS unsigned char* AH = F.lds; LAS unsigned char* AL = F.lds + 16 * APITCH;
        LAS float* PART = (LAS float*)(F.lds + 32 * APITCH);
        LAS float* LOGIT = (LAS float*)(F.lds + 32 * APITCH + 8 * 16 * 48 * 4);
        LAS int* DEC = (LAS int*)(F.lds + 32 * APITCH + 8 * 16 * 48 * 4 + 16 * 48 * 4);
        static_assert(32 * APITCH + 8 * 16 * 48 * 4 + 16 * 48 * 4 + 128 * 16 <= LDSCTL_OFF, "P5 LDS");
        volatile LAS int* HIST = (volatile LAS int*)(F.LC + LC_HIST); volatile LAS int* BASE = (volatile LAS int*)(F.LC + LC_BASE);
        int nt_done = 0;
        for (int task = vcu; task < TR / 16; task += G, ++nt_done) {
            for (int rr = 0; rr < 2; ++rr) { const int rl = 2 * wave + rr, m = task * 16 + rl;
                f32x4* rp = (f32x4*)(R + (size_t)m * DM) + lane; f32x4 v[8]; float s = 0.f;
#pragma unroll
                for (int j = 0; j < 8; ++j) { v[j] = rp[64 * j]; s += (v[j].x + v[j].y) + (v[j].z + v[j].w); }
                const float mean = wave_sum(s) * (1.f / DM); float s2 = 0.f;
#pragma unroll
                for (int j = 0; j < 8; ++j) { v[j] = v[j] - mean; s2 += (v[j].x * v[j].x + v[j].y * v[j].y) + (v[j].z * v[j].z + v[j].w * v[j].w); }
                const float rstd = 1.f / sqrtf(wave_sum(s2) * (1.f / DM) + LN_EPS);
                GAS u32x2* hb = (GAS u32x2*)(H1B + (size_t)m * DM) + lane;
#pragma unroll
                for (int j = 0; j < 8; ++j) { const f32x4 gg = ((const f32x4*)ln_mix_g)[lane + 64 * j], bb = ((const f32x4*)ln_mix_b)[lane + 64 * j];
                    const f32x4 h = v[j] * rstd * gg + bb; rp[64 * j] = h;
                    u32x2 hi; hi.x = cvt_pk_bf16(h.x, h.y); hi.y = cvt_pk_bf16(h.z, h.w); hb[64 * j] = hi;
                    u32x2 lo; lo.x = cvt_pk_bf16(h.x - bf16_lo(hi.x), h.y - bf16_hi(hi.x)); lo.y = cvt_pk_bf16(h.z - bf16_lo(hi.y), h.w - bf16_hi(hi.y));
                    *(LAS u32x2*)(AH + rl * APITCH + (4 * lane + 256 * j) * 2) = hi; *(LAS u32x2*)(AL + rl * APITCH + (4 * lane + 256 * j) * 2) = lo; } }
            __syncthreads();
#if STAGE >= 6
            { f32x4 acc[3] = {{0.f, 0.f, 0.f, 0.f}, {0.f, 0.f, 0.f, 0.f}, {0.f, 0.f, 0.f, 0.f}}; const int fr = lane & 15, fq = lane >> 4;
#pragma unroll 2
              for (int s = 0; s < 8; ++s) { const int k = 256 * wave + 32 * s + 8 * fq;
                  const bf16x8 yh = *(const LAS bf16x8*)(AH + fr * APITCH + k * 2), yl = *(const LAS bf16x8*)(AL + fr * APITCH + k * 2);
#pragma unroll
                  for (int ct = 0; ct < 3; ++ct) { const bf16x8 xh = *(const bf16x8*)(WRH + (size_t)(16 * ct + fr) * DM + k), xl = *(const bf16x8*)(WRL + (size_t)(16 * ct + fr) * DM + k);
                      acc[ct] = __builtin_amdgcn_mfma_f32_16x16x32_bf16(xh, yh, acc[ct], 0, 0, 0);
                      acc[ct] = __builtin_amdgcn_mfma_f32_16x16x32_bf16(xh, yl, acc[ct], 0, 0, 0);
                      acc[ct] = __builtin_amdgcn_mfma_f32_16x16x32_bf16(xl, yh, acc[ct], 0, 0, 0); } }
#pragma unroll
              for (int ct = 0; ct < 3; ++ct) *(LAS f32x4*)(PART + (wave * 16 + fr) * 48 + 16 * ct + 4 * fq) = acc[ct]; }
            __syncthreads();
            for (int i = tid; i < 16 * 48; i += 512) { float s = 0.f;
#pragma unroll
                for (int w = 0; w < 8; ++w) s += PART[w * 768 + i];
                LOGIT[i] = s; }
            __syncthreads();
            if (tid < 16) { const LAS float* lg = LOGIT + tid * 48; float gl[4]; int gi = 0;
#pragma unroll
                for (int q = 0; q < 4; ++q) gl[q] = lg[q] + b_rg[q];
                float gm = gl[0];
#pragma unroll
                for (int q = 1; q < 4; ++q) if (gl[q] > gm) { gm = gl[q]; gi = q; }
                float den = 0.f;
#pragma unroll
                for (int q = 0; q < 4; ++q) den += __expf(gl[q] - gm);
                const float pg = 1.f / den;
                float v0 = -__builtin_inff(), v1 = -__builtin_inff(); int i0 = 0, i1 = 0;
                for (int q = 0; q < 8; ++q) { const float l = lg[4 + gi * 8 + q] + b_re[gi * 8 + q];
                    if (l > v0) { v1 = v0; i1 = i0; v0 = l; i0 = q; } else if (l > v1) { v1 = l; i1 = q; } }
                const float e1 = __expf(v1 - v0), g0 = pg / (1.f + e1), g1 = pg * e1 / (1.f + e1);
                LAS int* d = DEC + (nt_done * 16 + tid) * 4; d[0] = gi * 8 + i0; d[1] = gi * 8 + i1; d[2] = __float_as_int(g0); d[3] = __float_as_int(g1); }
#endif
        }
#if STAGE >= 6
        __syncthreads();
        { const int ntok = nt_done * 16; int e = 0, rank = 0;
          if (tid < 2 * ntok) { e = DEC[(tid >> 1) * 4 + (tid & 1)]; rank = __hip_atomic_fetch_add((LAS int*)&HIST[e], 1, __ATOMIC_RELAXED, __HIP_MEMORY_SCOPE_WORKGROUP); }
          __syncthreads();
          if (tid < 32) { const int c = HIST[tid]; BASE[tid] = c ? (int)__hip_atomic_fetch_add((unsigned*)(F.ctl + CW_CNT + 64 * tid), (unsigned)c, __ATOMIC_RELAXED, __HIP_MEMORY_SCOPE_AGENT) : 0; }
          __syncthreads();
          if (tid < 2 * ntok) { const int lt = tid >> 1, k = tid & 1, pos = BASE[e] + rank, m = (vcu + G * (lt >> 4)) * 16 + (lt & 15);
              TOK[(size_t)e * TR + pos] = m; GATE[(size_t)e * TR + pos] = __int_as_float(DEC[lt * 4 + 2 + k]); TINFO[m * 4 + 2 * k] = e; TINFO[m * 4 + 2 * k + 1] = pos; } }
#endif
    }
    xcd_barrier(bar);

#if STAGE >= 7
    if (PH(6)) {
        const int tid = fresh_tid(), lane = tid & 63, wave = __builtin_amdgcn_readfirstlane(tid >> 6), gw = vcu * NWAVES + wave; (void)lane; (void)gw;
        volatile LAS int* TST = (volatile LAS int*)(F.LC + LC_TST); volatile LAS int* CNT = (volatile LAS int*)(F.LC + LC_CNT);
        if (tid == 0) { int acc = 0; for (int e = 0; e < NE; ++e) { const int c = (int)__hip_atomic_load((unsigned*)(F.ctl + CW_CNT + 64 * e), __ATOMIC_RELAXED, __HIP_MEMORY_SCOPE_AGENT); CNT[e] = c; TST[e] = acc; acc += (c + 255) >> 8; } TST[NE] = acc; }
        __syncthreads();

        {

            pg8::Gemm g{H1B, W13T, DM, DM, 2 * DE}; MoeSched<true> S{TST, CNT, TOK, G, vcu, DM}; EpiSwi E{HID};
            pg8::gemm_phase<EpiSwi, MoeSched<true>, true>(F.lds, g, S, E);
        }
        xcd_barrier(bar);
        {

            pg8::Gemm g{HID, W2T, DE, DE, DM}; MoeSched<false> S{TST, CNT, TOK, G, vcu, DE}; EpiDown E{EO, GATE, CNT};
            pg8::gemm_phase<EpiDown, MoeSched<false>, true>(F.lds, g, S, E);
        }
        xcd_barrier(bar);
    }
#endif

    if (PH(8)) {
        const int tid = fresh_tid(), lane = tid & 63, wave = __builtin_amdgcn_readfirstlane(tid >> 6), gw = vcu * NWAVES + wave; (void)lane; (void)gw;
        volatile LAS int* TST = (volatile LAS int*)(F.LC + LC_TST);
        const bool bad = __hip_atomic_load(F.ctl + CW_BAR + XB_TMO, __ATOMIC_RELAXED, __HIP_MEMORY_SCOPE_AGENT) != 0u;
        for (int m = gw; m < TR; m += NGW) {
            const f32x4* hp = (const f32x4*)(R + (size_t)m * DM) + lane; f32x4 v[8]; float s = 0.f;
#if STAGE >= 7
            const int e0 = TINFO[m * 4], p0 = TINFO[m * 4 + 1], e1 = TINFO[m * 4 + 2], p1 = TINFO[m * 4 + 3];
            const GAS u32x2* q0 = (const GAS u32x2*)(EO + ((size_t)TST[e0] * 256 + p0) * DM) + lane; const GAS u32x2* q1 = (const GAS u32x2*)(EO + ((size_t)TST[e1] * 256 + p1) * DM) + lane;
#endif
#pragma unroll
            for (int j = 0; j < 8; ++j) { v[j] = hp[64 * j] * ALPHA;
#if STAGE >= 7
                const u32x2 a = q0[64 * j], c = q1[64 * j];
                v[j].x += bf16_lo(a.x) + bf16_lo(c.x); v[j].y += bf16_hi(a.x) + bf16_hi(c.x); v[j].z += bf16_lo(a.y) + bf16_lo(c.y); v[j].w += bf16_hi(a.y) + bf16_hi(c.y);
#endif
                s += (v[j].x + v[j].y) + (v[j].z + v[j].w); }
            const float mean = wave_sum(s) * (1.f / DM); float s2 = 0.f;
#pragma unroll
            for (int j = 0; j < 8; ++j) { v[j] = v[j] - mean; s2 += (v[j].x * v[j].x + v[j].y * v[j].y) + (v[j].z * v[j].z + v[j].w * v[j].w); }
            const float rstd = 1.f / sqrtf(wave_sum(s2) * (1.f / DM) + LN_EPS);
            f32x4* op = (f32x4*)(out + (size_t)m * DM) + lane;
#pragma unroll
            for (int j = 0; j < 8; ++j) { const f32x4 gg = ((const f32x4*)ln_ffn_g)[lane + 64 * j], bb = ((const f32x4*)ln_ffn_b)[lane + 64 * j];
                f32x4 o = v[j] * rstd * gg + bb; if (bad) o = (f32x4){__builtin_nanf(""), __builtin_nanf(""), __builtin_nanf(""), __builtin_nanf("")}; op[64 * j] = o; }
        }
    }
}

extern "C" void kernel_launch(void* const* d_in, const int* in_sizes, int n_in, void* d_out, int out_size, void* d_ws, size_t ws_size, hipStream_t stream) {
    static int grid = 0;
    if (grid == 0) {
        if (n_in != 19 || out_size != TR * DM || ws_size < WS_END) { fprintf(stderr, "kernel_launch: unexpected shapes (n_in %d, out %d, ws %zu < %zu)\n", n_in, out_size, ws_size, (size_t)WS_END); grid = -1; return; }
        int dev = 0, cus = 0, per_cu = 0;
        if (hipGetDevice(&dev) != hipSuccess || hipDeviceGetAttribute(&cus, hipDeviceAttributeMultiprocessorCount, dev) != hipSuccess) { grid = -1; return; }
        if (hipFuncSetAttribute((const void*)fox_moe_fwd, hipFuncAttributeMaxDynamicSharedMemorySize, LDS_BYTES) != hipSuccess) { fprintf(stderr, "kernel_launch: hipFuncSetAttribute failed\n"); grid = -1; return; }
        if (hipOccupancyMaxActiveBlocksPerMultiprocessor(&per_cu, (const void*)fox_moe_fwd, NWAVES * 64, LDS_BYTES) != hipSuccess || per_cu < 1) { fprintf(stderr, "kernel_launch: occupancy query says %d\n", per_cu); }
        (void)hipGetLastError();
        if (cus < 256) { fprintf(stderr, "kernel_launch: built for a 256-CU device, found %d CUs\n", cus); grid = -1; return; }
        grid = 256;
    }
    if (grid < 0) return;
    if (hipMemsetAsync((char*)d_ws + WS_CTL, 0, CTL_ZERO_BYTES, stream) != hipSuccess) return;
    Args a{};
    for (int i = 0; i < 19; ++i) a.in[i] = (const float*)d_in[i];
    a.out = (float*)d_out; a.ws = (unsigned char*)d_ws;
    hipLaunchKernelGGL(fox_moe_fwd, dim3(grid), dim3(NWAVES * 64), LDS_BYTES, stream, a);
}
```

```cpp
#include <hip/hip_runtime.h>
#include <cstdio>
#include <cstdint>

#ifndef PHMASK
#define PHMASK 0xFFFFFF
#endif
#define PH(k) (((PHMASK) >> (k)) & 1)
#ifndef REPMASK
#define REPMASK 0
#endif
#define REP(k) _Pragma("nounroll") for (int rep_ = 0; rep_ < (((REPMASK) >> (k)) & 1) + 1; ++rep_)
#ifndef STAGE
#define STAGE 9
#endif

#define LAS __attribute__((address_space(3)))
#define GAS __attribute__((address_space(1)))
typedef unsigned short bf16_t;
typedef short bf16x8 __attribute__((ext_vector_type(8)));
typedef short s16x4 __attribute__((ext_vector_type(4)));
typedef float f32x4 __attribute__((ext_vector_type(4)));
typedef float f32x2 __attribute__((ext_vector_type(2)));
typedef float f32x16 __attribute__((ext_vector_type(16)));
typedef unsigned u32x4 __attribute__((ext_vector_type(4)));
typedef unsigned u32x2 __attribute__((ext_vector_type(2)));
typedef GAS unsigned gu32;

constexpr int DM = 2048, NB = 4, SEQ = 4096, NMETA = 16, LPOS = SEQ + NMETA, TR = NB * SEQ;
constexpr int NH = 8, HD = 128, DFOX = 1024, DPOOL = 1024, NIN = 4104, NINB = 4096;
constexpr int NE = 32, EPG = 8, NGRP = 4, DE = 1024;
constexpr int KROWS = NB * LPOS + 64;
constexpr int CPOS = 4160;
constexpr int PRMAX = 41216;
constexpr float LN_EPS = 1e-5f;
constexpr float ALPHA = 1.189207115002721f;
constexpr float LOG2E = 1.4426950408889634f;
constexpr float QSCALE = 0.08838834764831845f * LOG2E;
constexpr int NWAVES = 8;

constexpr size_t MiB = 1u << 20;
constexpr size_t WS_CTL = 0, CTL_ZERO_BYTES = 1 * MiB;
constexpr size_t WS_WIN = 1 * MiB;
constexpr size_t WS_WOUT = WS_WIN + 16 * MiB;
constexpr size_t WS_WPOOL = WS_WOUT + 8 * MiB;
constexpr size_t WS_WR = WS_WPOOL + 1 * MiB;
constexpr size_t WS_W13 = WS_WR + 1 * MiB;
constexpr size_t WS_W2 = WS_W13 + 256 * MiB;
constexpr size_t WS_H0 = WS_W2 + 128 * MiB;
constexpr size_t WS_ST0 = WS_H0 + 64 * MiB;
constexpr size_t WS_LF = WS_ST0 + 1 * MiB;
constexpr size_t WS_SLAB = WS_LF + 1 * MiB;
constexpr size_t WS_Q = WS_SLAB + 3 * MiB;
constexpr size_t WS_K = WS_Q + 32 * MiB;
constexpr size_t WS_V = WS_K + 33 * MiB;
constexpr size_t WS_U = WS_V + 33 * MiB;
constexpr size_t WS_POOLED = WS_U + 33 * MiB;
constexpr size_t WS_CAT = WS_POOLED + 32 * MiB;
constexpr size_t WS_R = WS_CAT + 64 * MiB;
constexpr size_t WS_H1B = WS_R + 128 * MiB;
constexpr size_t WS_TOK = WS_H1B + 64 * MiB;
constexpr size_t WS_GATE = WS_TOK + 2 * MiB;
constexpr size_t WS_TINFO = WS_GATE + 2 * MiB;
constexpr size_t WS_HID = WS_TINFO + 1 * MiB;
constexpr size_t WS_EO = WS_HID + 81 * MiB;
constexpr size_t WS_END = WS_EO + 161 * MiB;
static_assert((size_t)KROWS * 1024 * 2 <= 33 * MiB && (size_t)PRMAX * 1024 * 2 <= 81 * MiB && (size_t)PRMAX * 2048 * 2 <= 161 * MiB, "ws map");
constexpr int CW_TMO = 0, CW_BAR = 4096, CW_CNT = 8192;

constexpr int RING_BYTES = 131072;
constexpr int LDSCTL_OFF = 161792;
constexpr int LDS_BYTES = 163840;
constexpr int LC_BAR = 0;
constexpr int LC_TST = 16;
constexpr int LC_CNT = 64;
constexpr int LC_HIST = 96, LC_BASE = 128;
constexpr int LC_MST = 160;

__device__ __forceinline__ unsigned cvt_pk_bf16(float lo, float hi) { unsigned r; asm volatile("v_cvt_pk_bf16_f32 %0, %1, %2" : "=v"(r) : "v"(lo), "v"(hi)); return r; }
__device__ __forceinline__ int fresh_tid() { int t = threadIdx.x; asm volatile("" : "+v"(t)); return t; }
__device__ __forceinline__ float bf16_lo(unsigned w) { return __uint_as_float(w << 16); }
__device__ __forceinline__ float bf16_hi(unsigned w) { return __uint_as_float(w & 0xffff0000u); }
__device__ __forceinline__ float wave_sum(float v) {
#pragma unroll
    for (int o = 1; o < 64; o <<= 1) v += __shfl_xor(v, o);
    return v;
}

namespace pg8 {
constexpr int BM = 256, BK = 64, HALF = 128, HTB = HALF * BK * 2, STAGE_BYTES = 8 * HTB, NXCD = 8, WGM = 8;
__host__ __device__ __forceinline__ int lds_byte(int r, int c) { const int st = (r >> 4) * 2 + (c >> 5), rr = r & 15, cc = c & 31, ob = rr * 64 + cc * 2; return st * 1024 + (ob ^ (((ob >> 9) & 1) << 5)); }
__host__ __device__ __forceinline__ void stage_rc(int b, int& R, int& C) { const int st = b / 1024, sb = b % 1024, swz = sb ^ (((sb >> 9) & 1) << 5); R = (st >> 1) * 16 + swz / 64; C = (st & 1) * 32 + (swz % 64) / 2; }
__host__ __device__ __forceinline__ int perm32(int rho) { const int n = rho >> 4, i = rho & 15; return 8 * (i >> 2) + 4 * n + (i & 3); }

struct Unit { int pm, pn, e, lt; };
struct Gemm { const bf16_t* A; const bf16_t* Bt; int K; int lda; int nB; };

struct StaticOrder {
    static constexpr bool GATHER = false;
    int nM, nN, nwg, G, c, lda, acol;
    __device__ void init(int M, int N, int G_, int c_, int lda_, int acol_) { nM = M / BM; nN = N / BM; nwg = nM * nN; G = G_; c = c_; lda = lda_; acol = acol_; }
    __device__ bool next(int i, Unit& u) const {
        const long L = (long)i * G + c; if (L >= nwg) return false;
        int wgid = (int)L; { const int q = nwg / NXCD, r = nwg % NXCD, xcd = wgid % NXCD, off = wgid / NXCD; wgid = (xcd < r ? xcd * (q + 1) : r * (q + 1) + (xcd - r) * q) + off; }
        const int nig = WGM * nN, gid = wgid / nig, fm = gid * WGM, gsz = (nM - fm) < WGM ? (nM - fm) : WGM;
        u.pm = fm + ((wgid % nig) % gsz); u.pn = (wgid % nig) / gsz; u.e = 0; u.lt = 0; return true;
    }
    __device__ __forceinline__ unsigned a_row(const Unit& u, int r) const { return (unsigned)(u.pm * BM + r) * (unsigned)lda + (unsigned)acol; }
};
struct OneUnit {
    static constexpr bool GATHER = false;
    Unit u0; int lda, acol;
    __device__ bool next(int i, Unit& u) const { if (i) return false; u = u0; return true; }
    __device__ __forceinline__ unsigned a_row(const Unit& u, int r) const { return (unsigned)(u.pm * BM + r) * (unsigned)lda + (unsigned)acol; }
};

template <class Epi, class Sched, bool ALIGN_EPI>
__device__ __forceinline__ void gemm_phase(LAS unsigned char* lds, const Gemm g, const Sched& S, const Epi& E) {
    const int tid = fresh_tid(), wid = __builtin_amdgcn_readfirstlane(tid >> 6), lane = tid & 63, wr = wid >> 2, wc = wid & 3, fr = lane & 15, fq = lane >> 4;
    const int K = g.K, nt = K / BK;
    unsigned voffB[2];
#pragma unroll
    for (int i = 0; i < 2; ++i) { int R, C; stage_rc(tid * 16 + i * 8192, R, C); const int Rb = Epi::PERM ? ((R & ~31) + perm32(R & 31)) : R; voffB[i] = (unsigned)(Rb * K + C) * 2u; }
    const size_t kstep = (size_t)(BK * 2);
    const size_t hstep = (size_t)HALF * K * 2;
    const unsigned ldsw = (unsigned)wid * 1024u;
    const int aoff = lds_byte(wr * 64 + fr, fq * 8), boff = lds_byte(wc * 32 + fr, fq * 8);
#define PG8_SA(b, h) (((b) * 2 + (h)) * HTB)
#define PG8_SB(b, h) ((4 + (b) * 2 + (h)) * HTB)
#define PG8_STAGE(bufoff, gbase, voff) do { _Pragma("unroll") for (int _i = 0; _i < 2; ++_i) \
        __builtin_amdgcn_global_load_lds((const unsigned*)((const char*)(gbase) + (voff)[_i]), (LAS unsigned*)(lds + (bufoff) + ldsw + _i * 8192), 16, 0, 0); } while (0)
#define PG8_LDA(dst, b, h) do { _Pragma("unroll") for (int m = 0; m < 4; ++m) _Pragma("unroll") for (int k = 0; k < 2; ++k) dst[m][k] = *(const LAS bf16x8*)(lds + PG8_SA(b, h) + aoff + m * 2048 + k * 1024); } while (0)
#define PG8_LDB(dst, b, h) do { _Pragma("unroll") for (int n = 0; n < 2; ++n) _Pragma("unroll") for (int k = 0; k < 2; ++k) dst[n][k] = *(const LAS bf16x8*)(lds + PG8_SB(b, h) + boff + n * 2048 + k * 1024); } while (0)
#define PG8_MMA(ai, bj, At, Bt) do { __builtin_amdgcn_s_setprio(1); _Pragma("unroll") for (int m = 0; m < 4; ++m) _Pragma("unroll") for (int n = 0; n < 2; ++n) _Pragma("unroll") for (int k = 0; k < 2; ++k) \
        acc[ai][bj][m][n] = __builtin_amdgcn_mfma_f32_16x16x32_bf16(Bt[n][k], At[m][k], acc[ai][bj][m][n], 0, 0, 0); __builtin_amdgcn_s_setprio(0); } while (0)
#define PG8_WAIT_V(n) asm volatile("s_waitcnt vmcnt(" #n ")" ::: "memory")
#define PG8_WAIT_L(n) asm volatile("s_waitcnt lgkmcnt(" #n ")" ::: "memory")
#define PG8_BAR __builtin_amdgcn_s_barrier()
#define PG8_SCHED __builtin_amdgcn_sched_barrier(0)
#define PG8_AOFF(dst, u) do { _Pragma("unroll") for (int _i = 0; _i < 2; ++_i) { int _R, _C; stage_rc(tid * 16 + _i * 8192, _R, _C); _Pragma("unroll") for (int _h = 0; _h < 2; ++_h) dst[_h][_i] = (S.a_row(u, _h * HALF + _R) + (unsigned)_C) * 2u; } } while (0)
    Unit cur, nxt; int ui = 0;
    if (!S.next(0, cur)) return;
    f32x4 acc[2][2][4][2];
#pragma unroll
    for (int a = 0; a < 2; ++a)
#pragma unroll
        for (int b = 0; b < 2; ++b)
#pragma unroll
            for (int m = 0; m < 4; ++m)
#pragma unroll
                for (int n = 0; n < 2; ++n) acc[a][b][m][n] = (f32x4){0.f, 0.f, 0.f, 0.f};
    bf16x8 At[4][2], B0[2][2], B1[2][2];
    unsigned oC[2][2];
    PG8_AOFF(oC, cur);
    const char* aB = (const char*)g.A;
    const char* cB = (const char*)g.Bt + ((size_t)cur.e * g.nB + (size_t)cur.pn * BM) * (size_t)K * 2;
    PG8_STAGE(PG8_SB(0, 0), cB, voffB); PG8_STAGE(PG8_SB(0, 1), cB + hstep, voffB); PG8_STAGE(PG8_SA(0, 0), aB, oC[0]); PG8_STAGE(PG8_SA(0, 1), aB, oC[1]);
    if (wr == 1) PG8_BAR;
    PG8_WAIT_V(2); PG8_BAR;
    PG8_STAGE(PG8_SB(1, 0), cB + kstep, voffB); PG8_STAGE(PG8_SA(1, 0), aB + kstep, oC[0]); PG8_STAGE(PG8_SB(1, 1), cB + hstep + kstep, voffB);
    PG8_WAIT_V(6); PG8_BAR;
    for (;;) {
        const bool has_next = S.next(ui + 1, nxt);
        if (!has_next) nxt = cur;
        unsigned oN[2][2];
        if constexpr (Sched::GATHER) { PG8_AOFF(oN, nxt); }
        const char* nB = has_next ? (const char*)g.Bt + ((size_t)nxt.e * g.nB + (size_t)nxt.pn * BM) * (size_t)K * 2 : cB;
        for (int t = 0; t < nt; t += 2) {
            const bool last = (t == nt - 2);
            const char* a1 = aB + (size_t)(t + 1) * kstep;
            const char* a2 = last ? aB : aB + (size_t)(t + 2) * kstep; const char* b2 = last ? nB : cB + (size_t)(t + 2) * kstep;
            const char* a3 = a2 + kstep; const char* b3 = b2 + kstep;
            PG8_LDB(B0, 0, 0); PG8_LDB(B1, 0, 1); PG8_SCHED; PG8_LDA(At, 0, 0); PG8_STAGE(PG8_SA(1, 1), a1, oC[1]);
            if (last) {
                if constexpr (Sched::GATHER) {
#pragma unroll
                    for (int h = 0; h < 2; ++h)
#pragma unroll
                        for (int i = 0; i < 2; ++i) oC[h][i] = oN[h][i];
                } else { PG8_AOFF(oC, nxt); } }
            PG8_WAIT_V(8); PG8_WAIT_L(0); PG8_BAR; PG8_MMA(0, 0, At, B0); PG8_MMA(0, 1, At, B1); PG8_BAR; PG8_SCHED;
            PG8_LDA(At, 0, 1); PG8_STAGE(PG8_SB(0, 0), b2, voffB); PG8_STAGE(PG8_SB(0, 1), b2 + hstep, voffB); PG8_STAGE(PG8_SA(0, 0), a2, oC[0]);
            PG8_WAIT_V(8); PG8_WAIT_L(0); PG8_BAR; PG8_MMA(1, 0, At, B0); PG8_MMA(1, 1, At, B1); PG8_BAR; PG8_SCHED;
            PG8_LDB(B0, 1, 0); PG8_LDB(B1, 1, 1); PG8_SCHED; PG8_LDA(At, 1, 0); PG8_STAGE(PG8_SA(0, 1), a2, oC[1]);
            PG8_WAIT_V(8); PG8_WAIT_L(0); PG8_BAR; PG8_MMA(0, 0, At, B0); PG8_MMA(0, 1, At, B1); PG8_BAR; PG8_SCHED;
            PG8_LDA(At, 1, 1); PG8_STAGE(PG8_SB(1, 0), b3, voffB); PG8_STAGE(PG8_SB(1, 1), b3 + hstep, voffB); PG8_STAGE(PG8_SA(1, 0), a3, oC[0]);
            PG8_WAIT_V(8); PG8_WAIT_L(0); PG8_BAR; PG8_MMA(1, 0, At, B0); PG8_MMA(1, 1, At, B1); PG8_BAR; PG8_SCHED;
        }
        if constexpr (ALIGN_EPI) { if (wr == 0) PG8_BAR; }
        E(acc, cur, wr, wc, fr, fq);
        if (!has_next) break;
#pragma unroll
        for (int a = 0; a < 2; ++a)
#pragma unroll
            for (int b = 0; b < 2; ++b)
#pragma unroll
                for (int m = 0; m < 4; ++m)
#pragma unroll
                    for (int n = 0; n < 2; ++n) acc[a][b][m][n] = (f32x4){0.f, 0.f, 0.f, 0.f};
        cur = nxt; cB = nB; ++ui;
        if constexpr (ALIGN_EPI) { if (wr == 1) PG8_BAR; }
    }
    PG8_WAIT_V(0);
    if constexpr (!ALIGN_EPI) { if (wr == 0) PG8_BAR; }
    PG8_BAR;
#undef PG8_SA
#undef PG8_SB
#undef PG8_STAGE
#undef PG8_LDA
#undef PG8_LDB
#undef PG8_MMA
#undef PG8_WAIT_V
#undef PG8_WAIT_L
#undef PG8_BAR
#undef PG8_SCHED
#undef PG8_AOFF
}
}

#define XB_TMO      128
#define XB_XCNT(j)  (256  + 64 * (j))
#define XB_XSUB(j)  (1280 + 64 * (j))
#define XB_XGEN(j)  (2304 + 64 * (j))
#define XB_TOP      3328
#define XB_TOPGEN   3392
#define XCD_BAR_WORDS 3456
#define XB_SPIN_CAP (1u << 18)
__device__ __forceinline__ unsigned xb_ld(unsigned* p)              { return __hip_atomic_load(p, __ATOMIC_RELAXED, __HIP_MEMORY_SCOPE_AGENT); }
__device__ __forceinline__ unsigned xb_add(unsigned* p, unsigned v) { return __hip_atomic_fetch_add(p, v, __ATOMIC_RELAXED, __HIP_MEMORY_SCOPE_AGENT); }
__device__ __forceinline__ unsigned xb_xcc_id() { return (unsigned)__builtin_amdgcn_s_getreg((3 << 11) | 20) & 0xFu; }
#define XB_SPIN(cond, bar) do { unsigned _sp = 0; while (cond) { __builtin_amdgcn_s_sleep(1); \
    if ((++_sp & 255u) == 0u) { if (xb_ld(&(bar)[XB_TMO])) break; if (_sp > XB_SPIN_CAP) { atomicAdd(&(bar)[XB_TMO], 1u); break; } } } } while (0)
struct XcdBarrier { unsigned* bar; unsigned x; volatile LAS unsigned* st; };
__device__ __forceinline__ XcdBarrier xcd_barrier_post(unsigned* bar, volatile LAS unsigned* st) {
    XcdBarrier b; b.bar = bar; b.x = xb_xcc_id(); b.st = st;
    if (threadIdx.x == 0) (void)xb_add(&bar[XB_XCNT(b.x)], 1u);
    return b;
}
__device__ __forceinline__ void xcd_barrier_complete(unsigned* bar, unsigned x, unsigned& nloc, unsigned& nx) {
    const unsigned G = gridDim.x * gridDim.y * gridDim.z;
    unsigned sum, cnt, mine, sp = 0u;
    for (;;) {
        sum = 0u; cnt = 0u; mine = 0u;
#pragma unroll
        for (unsigned j = 0; j < 16; ++j) { const unsigned c = xb_ld(&bar[XB_XCNT(j)]); sum += c; cnt += (c > 0u) ? 1u : 0u; mine = (j == x) ? c : mine; }
        if (sum == G) break;
        __builtin_amdgcn_s_sleep(1);
        if ((++sp & 255u) == 0u) { if (xb_ld(&bar[XB_TMO])) break; if (sp > XB_SPIN_CAP) { atomicAdd(&bar[XB_TMO], 1u); break; } }
    }
    nloc = mine > 0u ? mine : 1u; nx = cnt > 0u ? cnt : 1u;
}
__device__ __forceinline__ void xcd_barrier(const XcdBarrier& b) {
    asm volatile("s_waitcnt vmcnt(0)" ::: "memory");
    __syncthreads();
    if (threadIdx.x == 0) {
        unsigned* bar = b.bar;
        __builtin_amdgcn_s_waitcnt(0);
        unsigned nloc = b.st[0], nx = b.st[1];
        if (nloc == 0u) { xcd_barrier_complete(bar, b.x, nloc, nx); b.st[0] = nloc; b.st[1] = nx; }
        const unsigned old = xb_add(&bar[XB_XSUB(b.x)], 1u);
        const unsigned gen = old / nloc;
        if (old + 1u == (gen + 1u) * nloc) {
            __builtin_amdgcn_fence(__ATOMIC_RELEASE, "agent");
            asm volatile("s_waitcnt vmcnt(0)" ::: "memory");
            const unsigned og = xb_add(&bar[XB_TOP], 1u);
            const unsigned tg = og / nx;
            if (og + 1u == (tg + 1u) * nx) xb_add(&bar[XB_TOPGEN], 1u);
            else XB_SPIN(xb_ld(&bar[XB_TOPGEN]) == tg, bar);
            __builtin_amdgcn_fence(__ATOMIC_ACQUIRE, "agent");
            xb_add(&bar[XB_XGEN(b.x)], 1u);
            asm volatile("s_waitcnt vmcnt(0)" ::: "memory");
        } else {
            XB_SPIN(xb_ld(&bar[XB_XGEN(b.x)]) == gen, bar);
            __builtin_amdgcn_fence(__ATOMIC_ACQUIRE, "agent");
            asm volatile("s_waitcnt vmcnt(0)" ::: "memory");
        }
    }
    __syncthreads();
}

namespace fox {
constexpr int D = 128, NW = 8, QBLK = 32, KVBLK = 64, QB = NW * QBLK;
constexpr int SHM_V = KVBLK * D * 2, SHM_K = KVBLK * D * 2;
constexpr int LDS_WS = 2 * SHM_V + 2 * SHM_K;
constexpr int LDS_C = LDS_WS + NW * 64 * 4;
constexpr int LDS_SC = LDS_C + CPOS * 4;
constexpr int LDS_END = LDS_SC + 64;
constexpr int KP = 1024, OP = 2048;
constexpr float THRL = 8.f * LOG2E;
#define KSWZ(row, colB) ((row) * 256 + ((colB) ^ (((row) & 7) << 4)))
#define SBAR() __builtin_amdgcn_sched_barrier(0)
__device__ __forceinline__ int v_st(int k, int c) { const int kk = (k & ~0xC) | ((k & 4) << 1) | ((k & 8) >> 1); return ((kk >> 3) * 4 + (c >> 5)) * 512 + ((kk & 7) * 32 + (c & 31)) * 2; }
__device__ __forceinline__ int v_rd_base(int lane) { return ((lane & 3) << 3) | (((lane >> 2) & 3) << 6) | (((lane >> 4) & 1) << 5) | (((lane >> 5) & 1) << 8); }
constexpr int v_rd_off(int d0, int ks, int half) { return d0 * 512 + ks * 4096 + half * 2048; }
__device__ __forceinline__ int crow(int r, int hi) { return (r & 3) + 8 * (r >> 2) + 4 * hi; }
__device__ __forceinline__ unsigned cvtpk(float lo, float hi) { unsigned r; asm volatile("v_cvt_pk_bf16_f32 %0, %1, %2" : "=v"(r) : "v"(lo), "v"(hi)); return r; }
__device__ __forceinline__ bf16x8 load8(const bf16_t* p) { return *reinterpret_cast<const bf16x8*>(p); }
__device__ __forceinline__ void mask_tile(f32x16& p0, f32x16& p1, int dq) {
    const float NEG = -__builtin_inff();
#pragma unroll
    for (int r = 0; r < 16; ++r) {
        const int c = (r & 3) + 8 * (r >> 2);
        if (dq - c < 0) p0[r] = NEG;
        if (dq - c - 32 < 0) p1[r] = NEG;
    }
}
__device__ __forceinline__ void partialSM(f32x16& p0, f32x16& p1, float& m_reg, float& mn, float& alpha) {
    float pmax = p0[0]; for (int r = 1; r < 16; ++r) pmax = fmaxf(pmax, p0[r]); for (int r = 0; r < 16; ++r) pmax = fmaxf(pmax, p1[r]);
    { auto rr = __builtin_amdgcn_permlane32_swap(__float_as_uint(pmax), __float_as_uint(pmax), false, false);
      pmax = fmaxf(__uint_as_float(rr[0]), __uint_as_float(rr[1])); }
    if (__builtin_expect(__all((pmax - m_reg) <= THRL), 1)) { mn = m_reg; alpha = 1.f; }
    else { mn = fmaxf(m_reg, pmax); alpha = __builtin_amdgcn_exp2f(m_reg - mn); m_reg = mn; }
    for (int r = 0; r < 16; ++r) p0[r] = p0[r] - mn; for (int r = 0; r < 16; ++r) p1[r] = p1[r] - mn;
    for (int r = 0; r < 16; ++r) p0[r] = __builtin_amdgcn_exp2f(p0[r]);
}
__device__ __forceinline__ void finishSM(f32x16& p0, f32x16& p1, float alpha, float& l_reg, bf16x8& pa0, bf16x8& pa1, bf16x8& pa2, bf16x8& pa3) {
    for (int r = 0; r < 16; ++r) p1[r] = __builtin_amdgcn_exp2f(p1[r]);
    float ps = 0; for (int r = 0; r < 16; ++r) ps += p0[r]; for (int r = 0; r < 16; ++r) ps += p1[r];
    { auto rr = __builtin_amdgcn_permlane32_swap(__float_as_uint(ps), __float_as_uint(ps), false, false);
      ps = __uint_as_float(rr[0]) + __uint_as_float(rr[1]); }
    l_reg = l_reg * alpha + ps;
#define PK4(P, B_, OUT) do { unsigned a0 = cvtpk(P[B_+0], P[B_+1]), a1 = cvtpk(P[B_+2], P[B_+3]);                          \
        unsigned b0 = cvtpk(P[B_+4], P[B_+5]), b1 = cvtpk(P[B_+6], P[B_+7]);                                             \
        auto r0 = __builtin_amdgcn_permlane32_swap(a0, b0, false, false); auto r1 = __builtin_amdgcn_permlane32_swap(a1, b1, false, false); \
        u32x4 w = {r0[0], r1[0], r0[1], r1[1]}; OUT = *reinterpret_cast<bf16x8*>(&w); } while (0)
    PK4(p0, 0, pa0); PK4(p0, 8, pa1); PK4(p1, 0, pa2); PK4(p1, 8, pa3);
#undef PK4
}
template <int KB>
__device__ __forceinline__ void qkt(f32x16& p0, f32x16& p1, const char* K_lds, int r32, int hi, const bf16x8* qr, const f32x4* cp) {
    { const f32x4 a0 = cp[0], a1 = cp[2], a2 = cp[4], a3 = cp[6], b0 = cp[8], b1 = cp[10], b2 = cp[12], b3 = cp[14];
      p0 = (f32x16){a0[0], a0[1], a0[2], a0[3], a1[0], a1[1], a1[2], a1[3], a2[0], a2[1], a2[2], a2[3], a3[0], a3[1], a3[2], a3[3]};
      p1 = (f32x16){b0[0], b0[1], b0[2], b0[3], b1[0], b1[1], b1[2], b1[3], b2[0], b2[1], b2[2], b2[3], b3[0], b3[1], b3[2], b3[3]}; }
    const char* kb[4];
#pragma unroll
    for (int dd = 0; dd < 4; ++dd) kb[dd] = K_lds + KB * SHM_K + KSWZ(r32, (dd * 16 + hi * 8) * 2);
#pragma unroll
    for (int d0 = 0; d0 < 8; ++d0) { const char* a = kb[d0 & 3] + (d0 >> 2) * 128;
        bf16x8 b0 = *reinterpret_cast<const bf16x8*>(a);
        bf16x8 b1 = *reinterpret_cast<const bf16x8*>(a + 32 * 256);
        p0 = __builtin_amdgcn_mfma_f32_32x32x16_bf16(b0, qr[d0], p0, 0, 0, 0);
        p1 = __builtin_amdgcn_mfma_f32_32x32x16_bf16(b1, qr[d0], p1, 0, 0, 0); }
}
template <int VB>
__device__ __forceinline__ void pv_tile(f32x16* o, int vb0, bf16x8 pa0, bf16x8 pa1, bf16x8 pa2, bf16x8 pa3) {
#define TRRD(dst, off) asm volatile("ds_read_b64_tr_b16 %0, %1 offset:%2" : "=&v"(dst) : "v"(vb0), "i"(off) : "memory")
#define PV_D0(d0) do { s16x4 l0, l1, l2, l3, h0, h1, h2, h3; constexpr int b_ = VB * SHM_V + v_rd_off(d0, 0, 0); \
        TRRD(l0, b_); TRRD(h0, b_ + 2048); TRRD(l1, b_ + 4096); TRRD(h1, b_ + 6144); TRRD(l2, b_ + 8192); TRRD(h2, b_ + 10240); TRRD(l3, b_ + 12288); TRRD(h3, b_ + 14336); \
        asm volatile("s_waitcnt lgkmcnt(0)" ::: "memory"); SBAR();   \
        o[d0] = __builtin_amdgcn_mfma_f32_32x32x16_bf16(pa0, (bf16x8){l0[0], l0[1], l0[2], l0[3], h0[0], h0[1], h0[2], h0[3]}, o[d0], 0, 0, 0);   \
        o[d0] = __builtin_amdgcn_mfma_f32_32x32x16_bf16(pa1, (bf16x8){l1[0], l1[1], l1[2], l1[3], h1[0], h1[1], h1[2], h1[3]}, o[d0], 0, 0, 0);   \
        o[d0] = __builtin_amdgcn_mfma_f32_32x32x16_bf16(pa2, (bf16x8){l2[0], l2[1], l2[2], l2[3], h2[0], h2[1], h2[2], h2[3]}, o[d0], 0, 0, 0);   \
        o[d0] = __builtin_amdgcn_mfma_f32_32x32x16_bf16(pa3, (bf16x8){l3[0], l3[1], l3[2], l3[3], h3[0], h3[1], h3[2], h3[3]}, o[d0], 0, 0, 0); } while (0)
    PV_D0(0); PV_D0(1); PV_D0(2); PV_D0(3);
#undef PV_D0
#undef TRRD
}
struct BlockRef { const bf16_t* Q; const bf16_t* K; const bf16_t* V; bf16_t* O; int P0; };
struct Seam { bf16x8 qr[8]; bf16x8 st_v0, st_v1, st_k0, st_k1; };
#define ROW(p, k0, rr) ((p) + (size_t)((k0) + (rr)) * KP + sc)
#define VMW() asm volatile("s_waitcnt vmcnt(0)" ::: "memory")
#define VMWN(n) asm volatile("s_waitcnt vmcnt(%0)" :: "i"(n) : "memory")
#define SLOAD_H(Kp, Vp, k0) do { S.st_v0 = load8(ROW(Vp, k0, sr)); S.st_v1 = load8(ROW(Vp, k0, 32 + sr));              \
                         S.st_k0 = load8(ROW(Kp, k0, sr)); S.st_k1 = load8(ROW(Kp, k0, 32 + sr)); } while (0)
#define SWRITE_HK(bf) do { *(bf16x8*)(K_lds + (bf) * SHM_K + kws) = S.st_k0; *(bf16x8*)(K_lds + (bf) * SHM_K + kws + 32 * 256) = S.st_k1; } while (0)
#define SWRITE_HV(bf) do { *(bf16x8*)(V_lds + (bf) * SHM_V + vst0) = S.st_v0; *(bf16x8*)(V_lds + (bf) * SHM_V + vst1) = S.st_v1; } while (0)
#define SWRITE_H(bf) do { SWRITE_HV(bf); SWRITE_HK(bf); } while (0)
__device__ __forceinline__ void prime(const BlockRef& cur, char* lds, Seam& S) {
    const int tid = fresh_tid(), wid = __builtin_amdgcn_readfirstlane(tid >> 6), lane = tid & 63, r32 = lane & 31, hi = lane >> 5;
    const int sr = tid >> 4, sc = (tid & 15) * 8, kws = KSWZ(sr, sc * 2); char* K_lds = lds + 2 * SHM_V;
    for (int d0 = 0; d0 < 8; ++d0) S.qr[d0] = load8(cur.Q + (size_t)(wid * QBLK + r32) * KP + d0 * 16 + hi * 8);
    SLOAD_H(cur.K, cur.V, 0); VMW(); SWRITE_HK(0);
    __syncthreads();
}
__device__ __forceinline__ void block(const BlockRef& cur, const BlockRef& nxt, char* lds, Seam& S) {
    const int tid = fresh_tid(), wid = __builtin_amdgcn_readfirstlane(tid >> 6), lane = tid & 63, r32 = lane & 31, hi = lane >> 5;
    const int NT = (cur.P0 + QB - 1) / KVBLK + 1;
    const int qlo = cur.P0 + wid * QBLK, qm = qlo + r32 - 4 * hi;
    char* V_lds = lds; char* K_lds = lds + 2 * SHM_V;
    float* ws = (float*)(lds + LDS_WS) + wid * 64; float* li_l = ws, * al_l = ws + 32;
    const f32x4* cl = (const f32x4*)(lds + LDS_C) + hi;
    float m_reg = -1e30f, l_reg = 0; f32x16 o[4] = {};
    const int sr = tid >> 4, sc = (tid & 15) * 8, vst0 = v_st(sr, sc), vst1 = v_st(32 + sr, sc), kws = KSWZ(sr, sc * 2);
    const int vb0 = (int)(uintptr_t)V_lds + v_rd_base(lane);
    const bf16_t* Kh = cur.K; const bf16_t* Vh = cur.V;
#define RESC(a) do { if (__any((a) < 1.f)) { if (hi == 0) al_l[r32] = (a); asm volatile("s_waitcnt lgkmcnt(0)" ::: "memory");              \
                     for (int d_ = 0; d_ < 4; ++d_) for (int r = 0; r < 16; ++r) o[d_][r] *= al_l[crow(r, hi)]; } } while (0)
#define KBASE(t) ((t) * KVBLK)
#define CP(t) (cl + (t) * (KVBLK / 4))
#define MASKT(P0_, P1_, t) do { const int kb_ = KBASE(t); if (kb_ + KVBLK - 1 > qlo) mask_tile(P0_, P1_, qm - kb_); } while (0)
    constexpr int NQL = 8;
#define SEAM_K0() do { VMWN(NQL); SWRITE_HK(0); SBAR(); } while (0)
    f32x16 pA0, pA1, pB0, pB1; float mnA, mnB, alA, alB; bf16x8 pa0, pa1, pa2, pa3;
    SWRITE_HV(0); SBAR();
    if (NT > 1) { SLOAD_H(Kh, Vh, KBASE(1)); }
    SBAR(); qkt<0>(pA0, pA1, K_lds, r32, hi, S.qr, CP(0));
    MASKT(pA0, pA1, 0); partialSM(pA0, pA1, m_reg, mnA, alA);
    if (NT > 1) { VMW(); SWRITE_H(1); }
    __syncthreads();
#define HALF_STEP(PX0, PX1, mnX, alX, PY0, PY1, alY, t, KB, VB, SB) do {                                                      \
        SBAR(); qkt<KB>(PX0, PX1, K_lds, r32, hi, S.qr, CP(t));                                                              \
        finishSM(PY0, PY1, alY, l_reg, pa0, pa1, pa2, pa3); SBAR();                                                           \
        if ((t) + 1 < NT) { SLOAD_H(Kh, Vh, KBASE((t) + 1)); SBAR(); }                                                        \
        pv_tile<VB>(o, vb0, pa0, pa1, pa2, pa3); MASKT(PX0, PX1, (t)); partialSM(PX0, PX1, m_reg, mnX, alX);                  \
        __syncthreads();                                                                                                      \
        if ((t) + 1 < NT) { VMW(); SWRITE_H(SB); }                                                                            \
        RESC(alX); __syncthreads(); } while (0)
    for (int t = 1; t + 1 < NT; t += 2) {
        HALF_STEP(pB0, pB1, mnB, alB, pA0, pA1, alA, t, 1, 0, 0);
        HALF_STEP(pA0, pA1, mnA, alA, pB0, pB1, alB, t + 1, 0, 1, 1);
    }
    const bool even = (NT & 1) == 0;
    if (even) { SBAR(); qkt<1>(pB0, pB1, K_lds, r32, hi, S.qr, CP(NT - 1)); SBAR(); }
    SLOAD_H(nxt.K, nxt.V, 0); SBAR();
#pragma unroll
    for (int d0 = 0; d0 < 8; ++d0) S.qr[d0] = load8(nxt.Q + (size_t)(wid * QBLK + r32) * KP + d0 * 16 + hi * 8);
    SBAR();
    finishSM(pA0, pA1, alA, l_reg, pa0, pa1, pa2, pa3); SBAR();
    pv_tile<0>(o, vb0, pa0, pa1, pa2, pa3);
    if (even) { MASKT(pB0, pB1, NT - 1); partialSM(pB0, pB1, m_reg, mnB, alB); __syncthreads(); RESC(alB);
        finishSM(pB0, pB1, alB, l_reg, pa0, pa1, pa2, pa3); SBAR(); pv_tile<1>(o, vb0, pa0, pa1, pa2, pa3); }
    SBAR(); SEAM_K0();
    if (hi == 0) li_l[r32] = l_reg; asm volatile("s_waitcnt lgkmcnt(0)" ::: "memory");
    float rli[16];
#pragma unroll
    for (int r = 0; r < 16; ++r) rli[r] = __builtin_amdgcn_rcpf(li_l[crow(r, hi)]);
    bf16_t* Ow = cur.O + (size_t)(wid * QBLK) * OP;
#pragma unroll
    for (int r = 0; r < 16; ++r) { const int orow = crow(r, hi);
#pragma unroll
        for (int d0 = 0; d0 < 4; ++d0) { const float v = o[d0][r] * rli[r];
            const float vn = __shfl_xor(v, 1);
            if ((r32 & 1) == 0) *(unsigned*)(Ow + (size_t)orow * OP + d0 * 32 + r32) = cvtpk(v, vn); } }
    __syncthreads();
#undef RESC
#undef KBASE
#undef CP
#undef MASKT
#undef SEAM_K0
#undef HALF_STEP
}
#undef ROW
#undef VMW
#undef VMWN
#undef SLOAD_H
#undef SWRITE_HK
#undef SWRITE_HV
#undef SWRITE_H
#undef KSWZ
#undef SBAR
}

struct Args {
    const float* in[19]; float* out; unsigned char* ws;
};
struct Frame {
    LAS unsigned char* lds; volatile LAS unsigned* LC; gu32* ctl; unsigned char* ws;
    int tid, lane, wave, vcu, G;
};

struct EpiIn {
            static constexpr bool PERM = true;
            bf16_t *Q, *K, *V, *U;
            __device__ __forceinline__ void operator()(const f32x4 (&acc)[2][2][4][2], const pg8::Unit& u, int wr, int wc, int fr, int fq) const {
                const int ty = u.pn >> 2, b = u.pm >> 4; const float sc = ty == 0 ? QSCALE : 1.f;
                bf16_t* base = ty == 0 ? Q : (ty == 1 ? K : (ty == 2 ? V : U));
                const int rowoff = ty == 0 ? 0 : NMETA * (b + 1);
                const int row0 = u.pm * 256 + rowoff + wr * 64 + fr, col0 = (u.pn & 3) * 256 + wc * 32 + 8 * fq;
#pragma unroll
                for (int ai = 0; ai < 2; ++ai)
#pragma unroll
                    for (int m = 0; m < 4; ++m) { bf16_t* rowp = base + (size_t)(row0 + ai * 128 + m * 16) * 1024 + col0;
#pragma unroll
                        for (int bj = 0; bj < 2; ++bj) { const f32x4 v0 = acc[ai][bj][m][0] * sc, v1 = acc[ai][bj][m][1] * sc;
                            u32x4 w; w.x = cvt_pk_bf16(v0[0], v0[1]); w.y = cvt_pk_bf16(v0[2], v0[3]); w.z = cvt_pk_bf16(v1[0], v1[1]); w.w = cvt_pk_bf16(v1[2], v1[3]);
                            *(u32x4*)(rowp + bj * 128) = w; } }
            }
        };
struct EpiPool {
                static constexpr bool PERM = true;
                bf16_t* O; const float* scale;
                __device__ __forceinline__ void operator()(const f32x4 (&acc)[2][2][4][2], const pg8::Unit& u, int wr, int wc, int fr, int fq) const {
                    const int row0 = u.pm * 256 + wr * 64 + fr, cl0 = wc * 32 + 8 * fq;
#pragma unroll
                    for (int bj = 0; bj < 2; ++bj) { const f32x4 s0 = *(const f32x4*)(scale + u.e * 256 + bj * 128 + cl0), s1 = *(const f32x4*)(scale + u.e * 256 + bj * 128 + cl0 + 4);
#pragma unroll
                        for (int ai = 0; ai < 2; ++ai)
#pragma unroll
                            for (int m = 0; m < 4; ++m) { const f32x4 v0 = acc[ai][bj][m][0] * s0, v1 = acc[ai][bj][m][1] * s1;
                                u32x4 w; w.x = cvt_pk_bf16(v0[0], v0[1]); w.y = cvt_pk_bf16(v0[2], v0[3]); w.z = cvt_pk_bf16(v1[0], v1[1]); w.w = cvt_pk_bf16(v1[2], v1[3]);
                                *(u32x4*)(O + (size_t)(row0 + ai * 128 + m * 16) * DM + DFOX + u.e * 256 + bj * 128 + cl0) = w; } }
                }
            };
struct EpiRes {
            static constexpr bool PERM = true;
            const bf16_t* H0; bf16_t* R;
            __device__ __forceinline__ void operator()(const f32x4 (&acc)[2][2][4][2], const pg8::Unit& u, int wr, int wc, int fr, int fq) const {
                const int row0 = u.pm * 256 + wr * 64 + fr, col0 = u.pn * 256 + wc * 32 + 8 * fq;
#pragma unroll
                for (int ai = 0; ai < 2; ++ai)
#pragma unroll
                    for (int m = 0; m < 4; ++m) { const size_t off = (size_t)(row0 + ai * 128 + m * 16) * DM + col0;
#pragma unroll
                        for (int bj = 0; bj < 2; ++bj) { const u32x4 h = *(const u32x4*)(H0 + off + bj * 128); const f32x4 a0 = acc[ai][bj][m][0], a1 = acc[ai][bj][m][1];
                            u32x4 w; w.x = cvt_pk_bf16(bf16_lo(h.x) * ALPHA + a0[0], bf16_hi(h.x) * ALPHA + a0[1]); w.y = cvt_pk_bf16(bf16_lo(h.y) * ALPHA + a0[2], bf16_hi(h.y) * ALPHA + a0[3]);
                            w.z = cvt_pk_bf16(bf16_lo(h.z) * ALPHA + a1[0], bf16_hi(h.z) * ALPHA + a1[1]); w.w = cvt_pk_bf16(bf16_lo(h.w) * ALPHA + a1[2], bf16_hi(h.w) * ALPHA + a1[3]);
                            *(u32x4*)(R + off + bj * 128) = w; } }
            }
        };
template <bool GATHER_> struct MoeSched {
            static constexpr bool GATHER = GATHER_;
            volatile LAS int* TST; volatile LAS int* CNT; const int* TOK; int G, vcu, lda;
            __device__ bool next(int i, pg8::Unit& u) const {
                const int L = i * G + vcu, tile = L >> 3; if (tile >= TST[NE]) return false;
                int e = 0; while (e < NE - 1 && TST[e + 1] <= tile) ++e;
                u.pm = tile; u.pn = L & 7; u.e = e; u.lt = tile - TST[e]; return true;
            }
            __device__ __forceinline__ unsigned a_row(const pg8::Unit& u, int r) const {
                if constexpr (GATHER_) { const int pos = u.lt * 256 + r; const int tok = pos < CNT[u.e] ? TOK[(size_t)u.e * TR + pos] : 0; return (unsigned)tok * (unsigned)lda; }
                return (unsigned)(u.pm * 256 + r) * (unsigned)lda;
            }
        };
struct EpiSwi {
                static constexpr bool PERM = true;
                bf16_t* HID;
                __device__ __forceinline__ void operator()(const f32x4 (&acc)[2][2][4][2], const pg8::Unit& u, int wr, int wc, int fr, int fq) const {
                    const int row0 = u.pm * 256 + wr * 64 + fr, col0 = u.pn * 128 + wc * 32 + 8 * fq;
#pragma unroll
                    for (int ai = 0; ai < 2; ++ai)
#pragma unroll
                        for (int m = 0; m < 4; ++m) { float hv[8];
#pragma unroll
                            for (int n = 0; n < 2; ++n)
#pragma unroll
                                for (int e = 0; e < 4; ++e) { const float gt = acc[ai][0][m][n][e], up = acc[ai][1][m][n][e];
                                    hv[4 * n + e] = gt * __builtin_amdgcn_rcpf(1.f + __builtin_amdgcn_exp2f(-gt * LOG2E)) * up; }
                            u32x4 w; w.x = cvt_pk_bf16(hv[0], hv[1]); w.y = cvt_pk_bf16(hv[2], hv[3]); w.z = cvt_pk_bf16(hv[4], hv[5]); w.w = cvt_pk_bf16(hv[6], hv[7]);
                            *(u32x4*)(HID + (size_t)(row0 + ai * 128 + m * 16) * DE + col0) = w; }
                }
            };
struct EpiDown {
                static constexpr bool PERM = true;
                bf16_t* EO; const float* GATE; volatile LAS int* CNT;
                __device__ __forceinline__ void operator()(const f32x4 (&acc)[2][2][4][2], const pg8::Unit& u, int wr, int wc, int fr, int fq) const {
                    const int rl0 = wr * 64 + fr, col0 = u.pn * 256 + wc * 32 + 8 * fq, cnt = CNT[u.e];
#pragma unroll
                    for (int ai = 0; ai < 2; ++ai)
#pragma unroll
                        for (int m = 0; m < 4; ++m) { const int rl = rl0 + ai * 128 + m * 16, pos = u.lt * 256 + rl; const float gt = pos < cnt ? GATE[(size_t)u.e * TR + pos] : 0.f;
                            bf16_t* rowp = EO + (size_t)(u.pm * 256 + rl) * DM + col0;
#pragma unroll
                            for (int bj = 0; bj < 2; ++bj) { const f32x4 v0 = acc[ai][bj][m][0] * gt, v1 = acc[ai][bj][m][1] * gt;
                                u32x4 w; w.x = cvt_pk_bf16(v0[0], v0[1]); w.y = cvt_pk_bf16(v0[2], v0[3]); w.z = cvt_pk_bf16(v1[0], v1[1]); w.w = cvt_pk_bf16(v1[2], v1[3]);
                                *(u32x4*)(rowp + bj * 128) = w; } }
                }
            };

__device__ __forceinline__ void transpose_item(const float* W, int ldw, int k0, int n0s, bf16_t* WT, int ldd, int n0d, LAS float* scr, int lane) {
#pragma unroll 8
    for (int i = 0; i < 32; ++i) { const int kk = 2 * i + (lane >> 5); scr[kk * 33 + (lane & 31)] = W[(size_t)(k0 + kk) * ldw + n0s + (lane & 31)]; }
    asm volatile("s_waitcnt lgkmcnt(0)" ::: "memory");
    const int c = lane & 7;
#pragma unroll
    for (int j = 0; j < 4; ++j) { const int n = (lane >> 3) + 8 * j; const LAS float* s = scr + (8 * c) * 33 + n;
        u32x4 o; o.x = cvt_pk_bf16(s[0 * 33], s[1 * 33]); o.y = cvt_pk_bf16(s[2 * 33], s[3 * 33]); o.z = cvt_pk_bf16(s[4 * 33], s[5 * 33]); o.w = cvt_pk_bf16(s[6 * 33], s[7 * 33]);
        *(GAS u32x4*)(WT + (size_t)(n0d + n) * ldd + k0 + 8 * c) = o; }
    asm volatile("s_waitcnt lgkmcnt(0)" ::: "memory");
}
__device__ __forceinline__ void router_item(const float* W, int ncols, int col, int drow, bf16_t* WH, bf16_t* WL, int lane) {
    for (int k = lane; k < DM; k += 64) { const float w = W[(size_t)k * ncols + col]; const unsigned h = cvt_pk_bf16(w, 0.f) & 0xffffu; const float r = w - __uint_as_float(h << 16);
        WH[(size_t)drow * DM + k] = (bf16_t)h; WL[(size_t)drow * DM + k] = (bf16_t)(cvt_pk_bf16(r, 0.f) & 0xffffu); }
}

__device__ __forceinline__ float log_sigmoid_f(float z) { return fminf(z, 0.f) - log1pf(__expf(-fabsf(z))); }

extern "C" __global__ void __launch_bounds__(NWAVES * 64, 2) fox_moe_fwd(Args args) {
    extern __shared__ __attribute__((aligned(16))) unsigned char lds_raw[];
    Frame F;
    F.lds = (LAS unsigned char*)lds_raw; F.LC = (volatile LAS unsigned*)(F.lds + LDSCTL_OFF);
    F.tid = threadIdx.x; F.lane = F.tid & 63; F.wave = __builtin_amdgcn_readfirstlane(F.tid >> 6);
    F.G = gridDim.x; { const int bx = blockIdx.x; F.vcu = (F.G % 8 == 0) ? (bx % 8) * (F.G / 8) + bx / 8 : bx; }
    F.ws = args.ws; F.ctl = (gu32*)(args.ws + WS_CTL);
    const int tid = F.tid, lane = F.lane, wave = F.wave, G = F.G, vcu = F.vcu;
    for (int u = tid; u < (LDS_BYTES - LDSCTL_OFF) / 4; u += NWAVES * 64) ((LAS unsigned*)(F.lds + LDSCTL_OFF))[u] = 0u;
    __syncthreads();
    XcdBarrier bar = xcd_barrier_post((unsigned*)(F.ctl + CW_BAR), F.LC + LC_BAR);

    const float* x = args.in[0]; const float* meta = args.in[1]; const float* ln_in_g = args.in[2]; const float* ln_in_b = args.in[3];
    const float* w_in = args.in[4]; const float* b_f = args.in[5]; const float* pool_w = args.in[6]; const float* pool_scale = args.in[7];
    const float* w_out = args.in[8]; const float* ln_mix_g = args.in[9]; const float* ln_mix_b = args.in[10];
    const float* w_rg = args.in[11]; const float* b_rg = args.in[12]; const float* w_re = args.in[13]; const float* b_re = args.in[14];
    const float* w13 = args.in[15]; const float* w2 = args.in[16]; const float* ln_ffn_g = args.in[17]; const float* ln_ffn_b = args.in[18];
    float* out = args.out; unsigned char* ws = args.ws;
    bf16_t* WIN = (bf16_t*)(ws + WS_WIN); bf16_t* WOUT = (bf16_t*)(ws + WS_WOUT); bf16_t* WPOOL = (bf16_t*)(ws + WS_WPOOL);
    bf16_t* WRH = (bf16_t*)(ws + WS_WR); bf16_t* WRL = WRH + 48 * DM;
    bf16_t* W13T = (bf16_t*)(ws + WS_W13); bf16_t* W2T = (bf16_t*)(ws + WS_W2);
    bf16_t* H0 = (bf16_t*)(ws + WS_H0); f32x2* ST0 = (f32x2*)(ws + WS_ST0); float* LF = (float*)(ws + WS_LF); float* SLAB = (float*)(ws + WS_SLAB);
    bf16_t* QB_ = (bf16_t*)(ws + WS_Q); bf16_t* KB_ = (bf16_t*)(ws + WS_K); bf16_t* VB_ = (bf16_t*)(ws + WS_V); bf16_t* UB_ = (bf16_t*)(ws + WS_U);
    bf16_t* POOLED = (bf16_t*)(ws + WS_POOLED); bf16_t* CAT = (bf16_t*)(ws + WS_CAT); bf16_t* R16 = (bf16_t*)(ws + WS_R); bf16_t* H1B = (bf16_t*)(ws + WS_H1B);
    int* TOK = (int*)(ws + WS_TOK); float* GATE = (float*)(ws + WS_GATE); int* TINFO = (int*)(ws + WS_TINFO);
    bf16_t* HID = (bf16_t*)(ws + WS_HID); bf16_t* EO = (bf16_t*)(ws + WS_EO);
    const int gw = vcu * NWAVES + wave, NGW = G * NWAVES;

    REP(0) if (PH(0)) {
        const int tid = fresh_tid(), lane = tid & 63, wave = __builtin_amdgcn_readfirstlane(tid >> 6), gw = vcu * NWAVES + wave; (void)lane; (void)gw;
        LAS float* WF = (LAS float*)(F.lds);
        LAS float* scr = (LAS float*)(F.lds + 65536 + wave * 8448);
        LAS float* MST = (LAS float*)(F.LC + LC_MST);
        for (int i = tid; i < DM * 8; i += NWAVES * 64) WF[i] = w_in[(size_t)(i >> 3) * NIN + 3 * DFOX + (i & 7)];
        for (int rr = 0; rr < 2; ++rr) { const int r = 2 * wave + rr; const f32x4* xr = (const f32x4*)(meta + (size_t)r * DM) + lane; f32x4 v[8]; float s = 0.f;
#pragma unroll
            for (int j = 0; j < 8; ++j) { v[j] = xr[64 * j]; s += (v[j].x + v[j].y) + (v[j].z + v[j].w); }
            const float mean = wave_sum(s) * (1.f / DM); float s2 = 0.f;
#pragma unroll
            for (int j = 0; j < 8; ++j) { v[j] = v[j] - mean; s2 += (v[j].x * v[j].x + v[j].y * v[j].y) + (v[j].z * v[j].z + v[j].w * v[j].w); }
            const float rstd = 1.f / sqrtf(wave_sum(s2) * (1.f / DM) + LN_EPS);
            if (lane == 0) { MST[2 * r] = mean; MST[2 * r + 1] = rstd; } }
        __syncthreads();
        if (PH(16)) for (int task = gw; task < 48 * 16; task += NGW) {
            const int cg = task % 48, kc = task / 48, k0 = kc * 128, sc = cg * 64 + lane, scol = 1024 + sc + (sc >= 2048 ? 8 : 0);
#pragma unroll
            for (int q = 0; q < 2; ++q) { const int kk = lane + 64 * q; const float gg = ln_in_g[k0 + kk], bb = ln_in_b[k0 + kk];
#pragma unroll
                for (int r = 0; r < 16; ++r) scr[kk * 16 + r] = (meta[(size_t)r * DM + k0 + kk] - MST[2 * r]) * MST[2 * r + 1] * gg + bb; }
            asm volatile("s_waitcnt lgkmcnt(0)" ::: "memory");
            float acc[16];
#pragma unroll
            for (int r = 0; r < 16; ++r) acc[r] = 0.f;
            for (int kk0 = 0; kk0 < 128; kk0 += 8) { float wv[8];
#pragma unroll
                for (int u = 0; u < 8; ++u) wv[u] = w_in[(size_t)(k0 + kk0 + u) * NIN + scol];
#pragma unroll
                for (int u = 0; u < 8; ++u) { const LAS f32x4* hp = (const LAS f32x4*)(scr + (kk0 + u) * 16); const float w = wv[u];
#pragma unroll
                    for (int q = 0; q < 4; ++q) { const f32x4 h = hp[q]; acc[4 * q] += w * h.x; acc[4 * q + 1] += w * h.y; acc[4 * q + 2] += w * h.z; acc[4 * q + 3] += w * h.w; }
                    asm volatile("" : "+v"(acc[0]), "+v"(acc[4]), "+v"(acc[8]), "+v"(acc[12]) :: "memory"); } }
#pragma unroll
            for (int r = 0; r < 16; ++r) SLAB[((size_t)kc * 16 + r) * 3072 + sc] = acc[r];
            asm volatile("s_waitcnt lgkmcnt(0)" ::: "memory");
        }
        if (PH(17)) {
        f32x4 GG[8], BB[8];
#pragma unroll
        for (int j = 0; j < 8; ++j) { GG[j] = ((const f32x4*)ln_in_g)[lane + 64 * j]; BB[j] = ((const f32x4*)ln_in_b)[lane + 64 * j]; }
        for (int m = gw; m < TR + NMETA; m += NGW) {
            const bool real = m < TR; const float* src = real ? x + (size_t)m * DM : meta + (size_t)(m - TR) * DM;
            const f32x4* xr = (const f32x4*)src + lane; f32x4 v[8]; float s = 0.f;
#pragma unroll
            for (int j = 0; j < 8; ++j) { v[j] = xr[64 * j]; s += (v[j].x + v[j].y) + (v[j].z + v[j].w); }
            const float mean = wave_sum(s) * (1.f / DM); float s2 = 0.f;
#pragma unroll
            for (int j = 0; j < 8; ++j) { v[j] = v[j] - mean; s2 += (v[j].x * v[j].x + v[j].y * v[j].y) + (v[j].z * v[j].z + v[j].w * v[j].w); }
            const float rstd = 1.f / sqrtf(wave_sum(s2) * (1.f / DM) + LN_EPS);
            float fl[8];
#pragma unroll
            for (int h = 0; h < 8; ++h) fl[h] = 0.f;
#pragma unroll
            for (int j = 0; j < 8; ++j) { v[j] = v[j] * rstd * GG[j] + BB[j];
                const LAS f32x4* wp = (const LAS f32x4*)(WF + (size_t)(4 * lane + 256 * j) * 8);
#pragma unroll
                for (int e = 0; e < 4; ++e) { const f32x4 w0 = wp[2 * e], w1 = wp[2 * e + 1]; const float hv = v[j][e];
                    fl[0] += hv * w0.x; fl[1] += hv * w0.y; fl[2] += hv * w0.z; fl[3] += hv * w0.w; fl[4] += hv * w1.x; fl[5] += hv * w1.y; fl[6] += hv * w1.z; fl[7] += hv * w1.w; }
                asm volatile("" : "+v"(fl[0]), "+v"(fl[1]), "+v"(fl[2]), "+v"(fl[3]), "+v"(fl[4]), "+v"(fl[5]), "+v"(fl[6]), "+v"(fl[7]) :: "memory"); }
            if (real) {
                GAS u32x2* o8 = (GAS u32x2*)(H0 + (size_t)m * DM) + lane;
#pragma unroll
                for (int j = 0; j < 8; ++j) { u32x2 w; w.x = cvt_pk_bf16(v[j].x, v[j].y); w.y = cvt_pk_bf16(v[j].z, v[j].w); o8[64 * j] = w; }
                (void)ST0;
            }
#pragma unroll
            for (int h = 0; h < 8; ++h) fl[h] = wave_sum(fl[h]);
            if (lane < 8) { float z = fl[0];
#pragma unroll
                for (int h = 1; h < 8; ++h) z = (lane == h) ? fl[h] : z;
                const float lfv = -LOG2E * log_sigmoid_f(z + b_f[lane]);
                if (real) { const int b = m >> 12, pos = NMETA + (m & 4095); LF[((size_t)b * NH + lane) * CPOS + pos] = lfv; }
                else { const int pos = m - TR;
#pragma unroll
                    for (int b = 0; b < NB; ++b) LF[((size_t)b * NH + lane) * CPOS + pos] = lfv; } }
        }
        }
        for (int i = gw * 64 + lane; i < NB * NH * (CPOS - LPOS); i += NGW * 64) { const int bh = i / (CPOS - LPOS), p = LPOS + i % (CPOS - LPOS); LF[(size_t)bh * CPOS + p] = 0.f; }
        for (int i = gw * 64 + lane; i < 64 * 1024 / 8; i += NGW * 64) { const u32x4 z = {0u, 0u, 0u, 0u}; const size_t o = (size_t)NB * LPOS * 1024 + (size_t)i * 8;
            *(GAS u32x4*)(KB_ + o) = z; *(GAS u32x4*)(VB_ + o) = z; *(GAS u32x4*)(UB_ + o) = z; }
        for (int c = gw; c < 48; c += NGW) {
            if (c < 4) router_item(w_rg, NGRP, c, c, WRH, WRL, lane);
            else if (c < 36) router_item(w_re, NE, c - 4, c, WRH, WRL, lane);
            else for (int k = lane; k < DM; k += 64) { WRH[(size_t)c * DM + k] = 0; WRL[(size_t)c * DM + k] = 0; }
        }
        if (PH(18)) {
            constexpr int I_IN = (DM / 64) * (NINB / 32), I_OUT = (DM / 64) * (DM / 32), I_POOL = NGRP * (256 / 64) * (256 / 32);
            constexpr int I_13E = (DM / 64) * (2 * DE / 32), I_13 = NE * I_13E, I_2E = (DE / 64) * (DM / 32), I_2 = NE * I_2E;
            constexpr int NITEMS = I_IN + I_OUT + I_POOL + I_13 + I_2;
            for (int it = gw; it < NITEMS; it += NGW) {
                int r = it;
                if (r < I_IN) { const int nblk = NINB / 32, kb = r / nblk, nb = r % nblk, n0d = 32 * nb, n0s = n0d + (n0d >= 3 * DFOX ? 8 : 0);
                    transpose_item(w_in, NIN, 64 * kb, n0s, WIN, DM, n0d, scr, lane); continue; } r -= I_IN;
                if (r < I_OUT) { const int nblk = DM / 32, kb = r / nblk, nb = r % nblk; transpose_item(w_out, DM, 64 * kb, 32 * nb, WOUT, DM, 32 * nb, scr, lane); continue; } r -= I_OUT;
                if (r < I_POOL) { const int g = r / 32, q = r % 32, kb = q / 8, nb = q % 8; transpose_item(pool_w + (size_t)g * 65536, 256, 64 * kb, 32 * nb, WPOOL + (size_t)g * 65536, 256, 32 * nb, scr, lane); continue; } r -= I_POOL;
                if (r < I_13) { const int e = r / I_13E, q = r % I_13E, nblk = 2 * DE / 32, kb = q / nblk, nb = q % nblk, n0s = 32 * nb, j = n0s % DE, up = n0s / DE, n0d = 256 * (j / 128) + 128 * up + (j % 128);
                    transpose_item(w13 + (size_t)e * DM * 2 * DE, 2 * DE, 64 * kb, n0s, W13T + (size_t)e * 2 * DE * DM, DM, n0d, scr, lane); continue; } r -= I_13;
                { const int e = r / I_2E, q = r % I_2E, nblk = DM / 32, kb = q / nblk, nb = q % nblk;
                    transpose_item(w2 + (size_t)e * DE * DM, DM, 64 * kb, 32 * nb, W2T + (size_t)e * DM * DE, DE, 32 * nb, scr, lane); }
            }
        }
    }
    xcd_barrier(bar);

    REP(1) if (PH(1)) {
        const int tid = fresh_tid(), lane = tid & 63, wave = __builtin_amdgcn_readfirstlane(tid >> 6), gw = vcu * NWAVES + wave; (void)lane; (void)gw;
        for (int o = (vcu * 512 + tid) * 4; o < 16 * 3072; o += G * 512 * 4) {
            const int r = o / 3072, sc = o % 3072; f32x4 s = {0.f, 0.f, 0.f, 0.f};
#pragma unroll
            for (int kc = 0; kc < 16; ++kc) s += *(const f32x4*)(SLAB + ((size_t)kc * 16 + r) * 3072 + sc);
            u32x2 w; w.x = cvt_pk_bf16(s.x, s.y); w.y = cvt_pk_bf16(s.z, s.w);
            bf16_t* dst = sc < 1024 ? KB_ : (sc < 2048 ? VB_ : UB_);
#pragma unroll
            for (int b = 0; b < NB; ++b) *(GAS u32x2*)(dst + ((size_t)b * LPOS + r) * 1024 + (sc & 1023)) = w;
        }

        pg8::Gemm g{H0, WIN, DM, DM, 0}; pg8::StaticOrder S; S.init(TR, NINB, G, (int)blockIdx.x, DM, 0);
        EpiIn E{QB_, KB_, VB_, UB_};
        pg8::gemm_phase<EpiIn, pg8::StaticOrder, true>(F.lds, g, S, E);
    }
    xcd_barrier(bar);

    REP(2) if (PH(2) && vcu < 256) { const int item = vcu;
        const int tid = fresh_tid(), lane = tid & 63, wave = __builtin_amdgcn_readfirstlane(tid >> 6), gw = vcu * NWAVES + wave; (void)lane; (void)gw;
        const int pm = item >> 2, gq = item & 3, wnd = 2 << gq;
        if (PH(19)) {
            const int cc = tid & 31, seg = tid >> 5, m0 = pm * 256 + seg * 16, b = m0 >> 12, kr0 = m0 + NMETA * (b + 1);
            const bf16_t* up = UB_ + (size_t)kr0 * 1024 + gq * 256 + cc * 8;
            float sum[8];
#pragma unroll
            for (int e = 0; e < 8; ++e) sum[e] = 0.f;
#pragma unroll 2
            for (int i = 1; i < wnd; ++i) { const u32x4 w = *(const GAS u32x4*)(up - (size_t)i * 1024);
                sum[0] += bf16_lo(w.x); sum[1] += bf16_hi(w.x); sum[2] += bf16_lo(w.y); sum[3] += bf16_hi(w.y); sum[4] += bf16_lo(w.z); sum[5] += bf16_hi(w.z); sum[6] += bf16_lo(w.w); sum[7] += bf16_hi(w.w); }
            const float inv = 1.f / (float)wnd;
#pragma unroll 4
            for (int i = 0; i < 16; ++i) {
                const u32x4 w = *(const GAS u32x4*)(up + (size_t)i * 1024); const u32x4 z = *(const GAS u32x4*)(up + (size_t)(i - wnd + 1) * 1024);
                float cur[8] = {bf16_lo(w.x), bf16_hi(w.x), bf16_lo(w.y), bf16_hi(w.y), bf16_lo(w.z), bf16_hi(w.z), bf16_lo(w.w), bf16_hi(w.w)};
                float old[8] = {bf16_lo(z.x), bf16_hi(z.x), bf16_lo(z.y), bf16_hi(z.y), bf16_lo(z.z), bf16_hi(z.z), bf16_lo(z.w), bf16_hi(z.w)};
                float o[8];
#pragma unroll
                for (int e = 0; e < 8; ++e) { sum[e] += cur[e]; o[e] = sum[e] * inv - cur[e]; sum[e] -= old[e]; }
                u32x4 ow; ow.x = cvt_pk_bf16(o[0], o[1]); ow.y = cvt_pk_bf16(o[2], o[3]); ow.z = cvt_pk_bf16(o[4], o[5]); ow.w = cvt_pk_bf16(o[6], o[7]);
                *(GAS u32x4*)(POOLED + (size_t)(m0 + i) * 1024 + gq * 256 + cc * 8) = ow;
            }
        }
        asm volatile("s_waitcnt vmcnt(0)" ::: "memory");
        __syncthreads();
        if (PH(20)) {
            int kpool = 256; asm volatile("" : "+s"(kpool));
            pg8::Gemm g{POOLED, WPOOL, kpool, 1024, 256}; pg8::OneUnit S; S.u0 = pg8::Unit{pm, 0, gq, 0}; S.lda = 1024; S.acol = gq * 256;
            EpiPool E{CAT, pool_scale};
            pg8::gemm_phase<EpiPool, pg8::OneUnit, false>(F.lds, g, S, E);
        }
#if STAGE >= 3
        if (PH(21)) {
            const int bh = item >> 3, y = item & 7, b = bh >> 3, h = bh & 7;
            char* lds = (char*)lds_raw;
            float* cl = (float*)(lds + fox::LDS_C); float* wsum = (float*)(lds + fox::LDS_SC);
            {
                const float* lf = LF + (size_t)bh * CPOS; float v[9]; float run = 0.f;
#pragma unroll
                for (int i = 0; i < 9; ++i) { const int p = tid * 9 + i; const float t = p < CPOS ? lf[p] : 0.f; run += t; v[i] = run; }
                float inc = run;
#pragma unroll
                for (int o = 1; o < 64; o <<= 1) { const float t = __shfl_up(inc, o); if (lane >= o) inc += t; }
                if (lane == 63) wsum[wave] = inc;
                __syncthreads();
                float off = inc - run;
                for (int w = 0; w < wave; ++w) off += wsum[w];
#pragma unroll
                for (int i = 0; i < 9; ++i) { const int p = tid * 9 + i; if (p < CPOS) cl[p] = v[i] + off; }
            }
            fox::BlockRef r0, r1;
            { const int i0 = y, i1 = 15 - y;
              r0.Q = QB_ + ((size_t)b * SEQ + 256 * i0) * 1024 + h * HD; r0.K = KB_ + (size_t)b * LPOS * 1024 + h * HD; r0.V = VB_ + (size_t)b * LPOS * 1024 + h * HD;
              r0.O = CAT + ((size_t)b * SEQ + 256 * i0) * DM + h * HD; r0.P0 = NMETA + 256 * i0;
              r1 = r0; r1.Q = QB_ + ((size_t)b * SEQ + 256 * i1) * 1024 + h * HD; r1.O = CAT + ((size_t)b * SEQ + 256 * i1) * DM + h * HD; r1.P0 = NMETA + 256 * i1; }
            fox::Seam S;
            fox::prime(r0, lds, S);
            fox::block(r0, r1, lds, S);
            fox::block(r1, r1, lds, S);
        }
#else
        { const bf16_t z = 0; const int bh = item >> 3, y = item & 7, b = bh >> 3, h = bh & 7;
          for (int q = 0; q < 2; ++q) { const int i0 = q ? 15 - y : y;
            for (int i = tid; i < 256 * 16; i += 512) { const int r = i >> 4, c = (i & 15) * 8; *(GAS u32x4*)(CAT + ((size_t)b * SEQ + 256 * i0 + r) * DM + h * HD + c) = (u32x4){0u, 0u, 0u, 0u}; } } (void)z; }
#endif
        asm volatile("s_waitcnt vmcnt(0)" ::: "memory");
        __syncthreads();
    }
    xcd_barrier(bar);

    REP(4) if (PH(4)) {
        const int tid = fresh_tid(), lane = tid & 63, wave = __builtin_amdgcn_readfirstlane(tid >> 6), gw = vcu * NWAVES + wave; (void)lane; (void)gw;

        pg8::Gemm g{CAT, WOUT, DM, DM, 0}; pg8::StaticOrder S; S.init(TR, DM, G, (int)blockIdx.x, DM, 0);
        EpiRes E{H0, R16};
        pg8::gemm_phase<EpiRes, pg8::StaticOrder, true>(F.lds, g, S, E);
    }
    xcd_barrier(bar);

    if (PH(5)) {
        const int tid = fresh_tid(), lane = tid & 63, wave = __builtin_amdgcn_readfirstlane(tid >> 6), gw = vcu * NWAVES + wave; (void)lane; (void)gw;
        constexpr int APITCH = 4112;
        LAS unsigned char* AH = F.lds; LAS unsigned char* AL = F.lds + 16 * APITCH;
        LAS float* PART = (LAS float*)(F.lds + 32 * APITCH);
        LAS float* LOGIT = (LAS float*)(F.lds + 32 * APITCH + 8 * 16 * 48 * 4);
        LAS int* DEC = (LAS int*)(F.lds + 32 * APITCH + 8 * 16 * 48 * 4 + 16 * 48 * 4);
        static_assert(32 * APITCH + 8 * 16 * 48 * 4 + 16 * 48 * 4 + 128 * 16 <= LDSCTL_OFF, "P5 LDS");
        volatile LAS int* HIST = (volatile LAS int*)(F.LC + LC_HIST); volatile LAS int* BASE = (volatile LAS int*)(F.LC + LC_BASE);
        int nt_done = 0;
        for (int task = vcu; task < TR / 16; task += G, ++nt_done) {
            for (int rr = 0; rr < 2; ++rr) { const int rl = 2 * wave + rr, m = task * 16 + rl;
                const GAS u32x2* rp = (const GAS u32x2*)(R16 + (size_t)m * DM) + lane; f32x4 v[8]; float s = 0.f;
#pragma unroll
                for (int j = 0; j < 8; ++j) { const u32x2 w = rp[64 * j]; v[j] = (f32x4){bf16_lo(w.x), bf16_hi(w.x), bf16_lo(w.y), bf16_hi(w.y)}; s += (v[j].x + v[j].y) + (v[j].z + v[j].w); }
                const float mean = wave_sum(s) * (1.f / DM); float s2 = 0.f;
#pragma unroll
                for (int j = 0; j < 8; ++j) { v[j] = v[j] - mean; s2 += (v[j].x * v[j].x + v[j].y * v[j].y) + (v[j].z * v[j].z + v[j].w * v[j].w); }
                const float rstd = 1.f / sqrtf(wave_sum(s2) * (1.f / DM) + LN_EPS);
                GAS u32x2* hb = (GAS u32x2*)(H1B + (size_t)m * DM) + lane;
#pragma unroll
                for (int j = 0; j < 8; ++j) { const f32x4 gg = ((const f32x4*)ln_mix_g)[lane + 64 * j], bb = ((const f32x4*)ln_mix_b)[lane + 64 * j];
                    const f32x4 h = v[j] * rstd * gg + bb;
                    u32x2 hi; hi.x = cvt_pk_bf16(h.x, h.y); hi.y = cvt_pk_bf16(h.z, h.w); hb[64 * j] = hi;
                    u32x2 lo; lo.x = cvt_pk_bf16(h.x - bf16_lo(hi.x), h.y - bf16_hi(hi.x)); lo.y = cvt_pk_bf16(h.z - bf16_lo(hi.y), h.w - bf16_hi(hi.y));
                    *(LAS u32x2*)(AH + rl * APITCH + (4 * lane + 256 * j) * 2) = hi; *(LAS u32x2*)(AL + rl * APITCH + (4 * lane + 256 * j) * 2) = lo; } }
            __syncthreads();
#if STAGE >= 6
            { f32x4 acc[3] = {{0.f, 0.f, 0.f, 0.f}, {0.f, 0.f, 0.f, 0.f}, {0.f, 0.f, 0.f, 0.f}}; const int fr = lane & 15, fq = lane >> 4;
#pragma unroll 2
              for (int s = 0; s < 8; ++s) { const int k = 256 * wave + 32 * s + 8 * fq;
                  const bf16x8 yh = *(const LAS bf16x8*)(AH + fr * APITCH + k * 2), yl = *(const LAS bf16x8*)(AL + fr * APITCH + k * 2);
#pragma unroll
                  for (int ct = 0; ct < 3; ++ct) { const bf16x8 xh = *(const bf16x8*)(WRH + (size_t)(16 * ct + fr) * DM + k), xl = *(const bf16x8*)(WRL + (size_t)(16 * ct + fr) * DM + k);
                      acc[ct] = __builtin_amdgcn_mfma_f32_16x16x32_bf16(xh, yh, acc[ct], 0, 0, 0);
                      acc[ct] = __builtin_amdgcn_mfma_f32_16x16x32_bf16(xh, yl, acc[ct], 0, 0, 0);
                      acc[ct] = __builtin_amdgcn_mfma_f32_16x16x32_bf16(xl, yh, acc[ct], 0, 0, 0); } }
#pragma unroll
              for (int ct = 0; ct < 3; ++ct) *(LAS f32x4*)(PART + (wave * 16 + fr) * 48 + 16 * ct + 4 * fq) = acc[ct]; }
            __syncthreads();
            for (int i = tid; i < 16 * 48; i += 512) { float s = 0.f;
#pragma unroll
                for (int w = 0; w < 8; ++w) s += PART[w * 768 + i];
                LOGIT[i] = s; }
            __syncthreads();
            if (tid < 16) { const LAS float* lg = LOGIT + tid * 48; float gl[4]; int gi = 0;
#pragma unroll
                for (int q = 0; q < 4; ++q) gl[q] = lg[q] + b_rg[q];
                float gm = gl[0];
#pragma unroll
                for (int q = 1; q < 4; ++q) if (gl[q] > gm) { gm = gl[q]; gi = q; }
                float den = 0.f;
#pragma unroll
                for (int q = 0; q < 4; ++q) den += __expf(gl[q] - gm);
                const float pg = 1.f / den;
                float v0 = -__builtin_inff(), v1 = -__builtin_inff(); int i0 = 0, i1 = 0;
                for (int q = 0; q < 8; ++q) { const float l = lg[4 + gi * 8 + q] + b_re[gi * 8 + q];
                    if (l > v0) { v1 = v0; i1 = i0; v0 = l; i0 = q; } else if (l > v1) { v1 = l; i1 = q; } }
                const float e1 = __expf(v1 - v0), g0 = pg / (1.f + e1), g1 = pg * e1 / (1.f + e1);
                LAS int* d = DEC + (nt_done * 16 + tid) * 4; d[0] = gi * 8 + i0; d[1] = gi * 8 + i1; d[2] = __float_as_int(g0); d[3] = __float_as_int(g1); }
#endif
        }
#if STAGE >= 6
        __syncthreads();
        { const int ntok = nt_done * 16; int e = 0, rank = 0;
          if (tid < 2 * ntok) { e = DEC[(tid >> 1) * 4 + (tid & 1)]; rank = __hip_atomic_fetch_add((LAS int*)&HIST[e], 1, __ATOMIC_RELAXED, __HIP_MEMORY_SCOPE_WORKGROUP); }
          __syncthreads();
          if (tid < 32) { const int c = HIST[tid]; BASE[tid] = c ? (int)__hip_atomic_fetch_add((unsigned*)(F.ctl + CW_CNT + 64 * tid), (unsigned)c, __ATOMIC_RELAXED, __HIP_MEMORY_SCOPE_AGENT) : 0; }
          __syncthreads();
          if (tid < 2 * ntok) { const int lt = tid >> 1, k = tid & 1, pos = BASE[e] + rank, m = (vcu + G * (lt >> 4)) * 16 + (lt & 15);
              TOK[(size_t)e * TR + pos] = m; GATE[(size_t)e * TR + pos] = __int_as_float(DEC[lt * 4 + 2 + k]); TINFO[m * 4 + 2 * k] = e; TINFO[m * 4 + 2 * k + 1] = pos; } }
#endif
    }
    xcd_barrier(bar);

#if STAGE >= 7
    if (PH(6)) {
        const int tid = fresh_tid(), lane = tid & 63, wave = __builtin_amdgcn_readfirstlane(tid >> 6), gw = vcu * NWAVES + wave; (void)lane; (void)gw;
        volatile LAS int* TST = (volatile LAS int*)(F.LC + LC_TST); volatile LAS int* CNT = (volatile LAS int*)(F.LC + LC_CNT);
        if (tid == 0) { int acc = 0; for (int e = 0; e < NE; ++e) { const int c = (int)__hip_atomic_load((unsigned*)(F.ctl + CW_CNT + 64 * e), __ATOMIC_RELAXED, __HIP_MEMORY_SCOPE_AGENT); CNT[e] = c; TST[e] = acc; acc += (c + 255) >> 8; } TST[NE] = acc; }
        __syncthreads();

        REP(6) {

            pg8::Gemm g{H1B, W13T, DM, DM, 2 * DE}; MoeSched<true> S{TST, CNT, TOK, G, vcu, DM}; EpiSwi E{HID};
            pg8::gemm_phase<EpiSwi, MoeSched<true>, true>(F.lds, g, S, E);
        }
        xcd_barrier(bar);
        REP(7) {

            pg8::Gemm g{HID, W2T, DE, DE, DM}; MoeSched<false> S{TST, CNT, TOK, G, vcu, DE}; EpiDown E{EO, GATE, CNT};
            pg8::gemm_phase<EpiDown, MoeSched<false>, true>(F.lds, g, S, E);
        }
        xcd_barrier(bar);
    }
#endif

    REP(8) if (PH(8)) {
        const int tid = fresh_tid(), lane = tid & 63, wave = __builtin_amdgcn_readfirstlane(tid >> 6), gw = vcu * NWAVES + wave; (void)lane; (void)gw;
        volatile LAS int* TST = (volatile LAS int*)(F.LC + LC_TST);
        const bool bad = __hip_atomic_load(F.ctl + CW_BAR + XB_TMO, __ATOMIC_RELAXED, __HIP_MEMORY_SCOPE_AGENT) != 0u;
        for (int m = gw; m < TR; m += NGW) {
            const GAS u32x2* hp = (const GAS u32x2*)(H1B + (size_t)m * DM) + lane; f32x4 v[8]; float s = 0.f;
#if STAGE >= 7
            const int e0 = TINFO[m * 4], p0 = TINFO[m * 4 + 1], e1 = TINFO[m * 4 + 2], p1 = TINFO[m * 4 + 3];
            const GAS u32x2* q0 = (const GAS u32x2*)(EO + ((size_t)TST[e0] * 256 + p0) * DM) + lane; const GAS u32x2* q1 = (const GAS u32x2*)(EO + ((size_t)TST[e1] * 256 + p1) * DM) + lane;
#endif
#pragma unroll
            for (int j = 0; j < 8; ++j) { const u32x2 hw = hp[64 * j]; v[j] = (f32x4){bf16_lo(hw.x), bf16_hi(hw.x), bf16_lo(hw.y), bf16_hi(hw.y)} * ALPHA;
#if STAGE >= 7
                const u32x2 a = q0[64 * j], c = q1[64 * j];
                v[j].x += bf16_lo(a.x) + bf16_lo(c.x); v[j].y += bf16_hi(a.x) + bf16_hi(c.x); v[j].z += bf16_lo(a.y) + bf16_lo(c.y); v[j].w += bf16_hi(a.y) + bf16_hi(c.y);
#endif
                s += (v[j].x + v[j].y) + (v[j].z + v[j].w); }
            const float mean = wave_sum(s) * (1.f / DM); float s2 = 0.f;
#pragma unroll
            for (int j = 0; j < 8; ++j) { v[j] = v[j] - mean; s2 += (v[j].x * v[j].x + v[j].y * v[j].y) + (v[j].z * v[j].z + v[j].w * v[j].w); }
            const float rstd = 1.f / sqrtf(wave_sum(s2) * (1.f / DM) + LN_EPS);
            f32x4* op = (f32x4*)(out + (size_t)m * DM) + lane;
#pragma unroll
            for (int j = 0; j < 8; ++j) { const f32x4 gg = ((const f32x4*)ln_ffn_g)[lane + 64 * j], bb = ((const f32x4*)ln_ffn_b)[lane + 64 * j];
                f32x4 o = v[j] * rstd * gg + bb; if (bad) o = (f32x4){__builtin_nanf(""), __builtin_nanf(""), __builtin_nanf(""), __builtin_nanf("")}; op[64 * j] = o; }
        }
    }
}

extern "C" void kernel_launch(void* const* d_in, const int* in_sizes, int n_in, void* d_out, int out_size, void* d_ws, size_t ws_size, hipStream_t stream) {
    static int grid = 0;
    if (grid == 0) {
        if (n_in != 19 || out_size != TR * DM || ws_size < WS_END) { fprintf(stderr, "kernel_launch: unexpected shapes (n_in %d, out %d, ws %zu < %zu)\n", n_in, out_size, ws_size, (size_t)WS_END); grid = -1; return; }
        int dev = 0, cus = 0, per_cu = 0;
        if (hipGetDevice(&dev) != hipSuccess || hipDeviceGetAttribute(&cus, hipDeviceAttributeMultiprocessorCount, dev) != hipSuccess) { grid = -1; return; }
        if (hipFuncSetAttribute((const void*)fox_moe_fwd, hipFuncAttributeMaxDynamicSharedMemorySize, LDS_BYTES) != hipSuccess) { fprintf(stderr, "kernel_launch: hipFuncSetAttribute failed\n"); grid = -1; return; }
        if (hipOccupancyMaxActiveBlocksPerMultiprocessor(&per_cu, (const void*)fox_moe_fwd, NWAVES * 64, LDS_BYTES) != hipSuccess || per_cu < 1) { fprintf(stderr, "kernel_launch: occupancy query says %d\n", per_cu); }
        (void)hipGetLastError();
        if (cus < 256) { fprintf(stderr, "kernel_launch: built for a 256-CU device, found %d CUs\n", cus); grid = -1; return; }
        grid = 256;
    }
    if (grid < 0) return;
    if (hipMemsetAsync((char*)d_ws + WS_CTL, 0, CTL_ZERO_BYTES, stream) != hipSuccess) return;
    Args a{};
    for (int i = 0; i < 19; ++i) a.in[i] = (const float*)d_in[i];
    a.out = (float*)d_out; a.ws = (unsigned char*)d_ws;
    hipLaunchKernelGGL(fox_moe_fwd, dim3(grid), dim3(NWAVES * 64), LDS_BYTES, stream, a);
}
```
